# Optimizing an MI355X kernel written in HIP

```python
import math
import jax, jax.numpy as jnp
from jax import lax
import numpy as np

D_MODEL = 1024
BATCH = 4
SEQ = 8192
DEPTH = 4

BLOCK = 128
MLA_HEADS = 6
MLA_Q_RANK = 192
MLA_KV_RANK = 128
MLA_NOPE = 64
MLA_ROPE = 32
MLA_V = 64
DIFF_HEADS = 4
DIFF_QK = 32
DIFF_V = 64
SWA_HEADS = 6
SWA_KV_HEADS = 2
SWA_DIM = 64
WINDOW = 128
W_MLA = MLA_HEADS * MLA_V
W_DIFF = DIFF_HEADS * DIFF_V
W_SWA = SWA_HEADS * SWA_DIM
D_MIX = W_MLA + W_DIFF + W_SWA
IN_SIZES = (MLA_Q_RANK, MLA_KV_RANK, MLA_ROPE,
            DIFF_HEADS * 2 * DIFF_QK, DIFF_HEADS * 2 * DIFF_QK, W_DIFF,
            W_SWA, SWA_KV_HEADS * SWA_DIM, SWA_KV_HEADS * SWA_DIM,
            D_MIX)
D_IN = sum(IN_SIZES)
REL_BUCKETS = 32
REL_MAX_DIST = 128
BIAS_HEADS = DIFF_HEADS + SWA_HEADS
ROPE_THETA = 10000.0
DEEPNORM_ALPHA = (2 * DEPTH) ** 0.25
DEEPNORM_BETA = (8 * DEPTH) ** -0.25

kernel_name = "hymba_style_mla_diff_swa_encoder"


def rms_norm(x, g, eps=1e-6):
    xf = x.astype(jnp.float32)
    y = xf * lax.rsqrt(jnp.mean(xf * xf, axis=-1, keepdims=True) + eps)
    return (y * g.astype(jnp.float32)).astype(x.dtype)


def layer_norm(x, g, b, eps=1e-5):
    xf = x.astype(jnp.float32)
    mu = jnp.mean(xf, axis=-1, keepdims=True)
    var = jnp.mean(jnp.square(xf - mu), axis=-1, keepdims=True)
    y = (xf - mu) * lax.rsqrt(var + eps) * g.astype(jnp.float32) + b.astype(jnp.float32)
    return y.astype(x.dtype)


def t5_bucket(rel):
    half = REL_BUCKETS // 2
    max_exact = half // 2
    ret = jnp.where(rel > 0, half, 0)
    n = jnp.abs(rel)
    nf = jnp.maximum(n, 1).astype(jnp.float32)
    large = max_exact + (jnp.log(nf / max_exact) / math.log(REL_MAX_DIST / max_exact)
                         * (half - max_exact)).astype(jnp.int32)
    large = jnp.minimum(large, half - 1)
    return ret + jnp.where(n < max_exact, n, large)


def rope(x, pos):
    half = x.shape[-1] // 2
    freqs = ROPE_THETA ** (-jnp.arange(half, dtype=jnp.float32) / half)
    ang = pos.astype(jnp.float32)[:, None] * freqs[None, :]
    cos = jnp.cos(ang)[None, :, None, :]
    sin = jnp.sin(ang)[None, :, None, :]
    xf = x.astype(jnp.float32)
    x1, x2 = xf[..., :half], xf[..., half:]
    return jnp.concatenate([x1 * cos - x2 * sin, x2 * cos + x1 * sin], axis=-1).astype(x.dtype)


def to_blocks(t):
    b, s = t.shape[:2]
    return jnp.moveaxis(t.reshape(b, s // BLOCK, BLOCK, *t.shape[2:]), 1, 0)


def from_blocks(t):
    nb, b = t.shape[:2]
    return jnp.moveaxis(t, 0, 1).reshape(b, nb * BLOCK, *t.shape[3:])


def mla_attention(c_q, c_kv, k_rope_in, q_norm, kv_norm, w_uq, w_ukv, pos):
    b, s, _ = c_q.shape
    q = (rms_norm(c_q, q_norm) @ w_uq).reshape(b, s, MLA_HEADS, MLA_NOPE + MLA_ROPE)
    q_nope = q[..., :MLA_NOPE]
    q_rope = rope(q[..., MLA_NOPE:], pos)
    kv = (rms_norm(c_kv, kv_norm) @ w_ukv).reshape(b, s, MLA_HEADS, MLA_NOPE + MLA_V)
    k_nope, v = kv[..., :MLA_NOPE], kv[..., MLA_NOPE:]
    k_rope = rope(k_rope_in[:, :, None, :], pos)[:, :, 0, :]
    scale = 1.0 / math.sqrt(MLA_NOPE + MLA_ROPE)

    def block(args):
        qn, qr = args
        sc = (jnp.einsum('bqhd,bkhd->bhqk', qn, k_nope)
              + jnp.einsum('bqhr,bkr->bhqk', qr, k_rope))
        p = jax.nn.softmax(sc.astype(jnp.float32) * scale, axis=-1)
        return jnp.einsum('bhqk,bkhd->bqhd', p.astype(v.dtype), v)

    o = lax.map(block, (to_blocks(q_nope), to_blocks(q_rope)))
    return from_blocks(o).reshape(b, s, W_MLA)


def diff_attention(q, k, v, lam_vecs, subln, rel_bias, lam_init):
    b, s, _ = q.shape
    nb = s // BLOCK
    q = q.reshape(b, s, DIFF_HEADS, 2, DIFF_QK)
    k = k.reshape(b, s, DIFF_HEADS, 2, DIFF_QK)
    v = v.reshape(b, s, DIFF_HEADS, DIFF_V)
    lv = lam_vecs.astype(jnp.float32)
    lam = jnp.exp(jnp.sum(lv[0] * lv[1])) - jnp.exp(jnp.sum(lv[2] * lv[3])) + lam_init
    table = rel_bias[:, :DIFF_HEADS].T.astype(jnp.float32)
    kpos = jnp.arange(s, dtype=jnp.int32)
    scale = 1.0 / math.sqrt(DIFF_QK)

    def block(args):
        qb, bi = args
        qpos = bi * BLOCK + jnp.arange(BLOCK, dtype=jnp.int32)
        bias = table[:, t5_bucket(kpos[None, :] - qpos[:, None])]
        sc = jnp.einsum('bqhmd,bkhmd->bmhqk', qb, k).astype(jnp.float32) * scale + bias[None, None]
        p = jax.nn.softmax(sc, axis=-1)
        a = p[:, 0] - lam * p[:, 1]
        return jnp.einsum('bhqk,bkhd->bqhd', a.astype(v.dtype), v)

    o = from_blocks(lax.map(block, (to_blocks(q), jnp.arange(nb, dtype=jnp.int32))))
    o = rms_norm(o, subln) * (1.0 - lam_init)
    return o.reshape(b, s, W_DIFF)


def swa_attention(q, k, v, sink, rel_bias):
    b, s, _ = q.shape
    nb = s // BLOCK
    grp = SWA_HEADS // SWA_KV_HEADS
    q = q.reshape(b, nb, BLOCK, SWA_KV_HEADS, grp, SWA_DIM)
    pad = ((0, 0), (BLOCK, BLOCK), (0, 0), (0, 0))

    def windows(t):
        tb = jnp.pad(t.reshape(b, s, SWA_KV_HEADS, SWA_DIM), pad).reshape(
            b, nb + 2, BLOCK, SWA_KV_HEADS, SWA_DIM)
        return jnp.concatenate([tb[:, :-2], tb[:, 1:-1], tb[:, 2:]], axis=2)

    kw, vw = windows(k), windows(v)
    rel = (jnp.arange(3 * BLOCK, dtype=jnp.int32) - BLOCK)[None, :] - jnp.arange(BLOCK, dtype=jnp.int32)[:, None]
    table = rel_bias[:, DIFF_HEADS:].T.astype(jnp.float32)
    bias = table[:, t5_bucket(rel)].reshape(SWA_KV_HEADS, grp, BLOCK, 3 * BLOCK)
    kpos = (jnp.arange(nb, dtype=jnp.int32)[:, None] * BLOCK - BLOCK
            + jnp.arange(3 * BLOCK, dtype=jnp.int32)[None, :])
    mask = (jnp.abs(rel) <= WINDOW)[None] & ((kpos >= 0) & (kpos < s))[:, None, :]
    scale = 1.0 / math.sqrt(SWA_DIM)
    sc = jnp.einsum('bnqgrd,bnkgd->bngrqk', q, kw).astype(jnp.float32) * scale + bias[None, None]
    sc = jnp.where(mask[None, :, None, None], sc, -jnp.inf)
    sink_l = sink.astype(jnp.float32).reshape(SWA_KV_HEADS, grp)[None, None, :, :, None, None]
    m = jnp.maximum(jnp.max(sc, axis=-1, keepdims=True), sink_l)
    p = jnp.exp(sc - m)
    p = p / (jnp.sum(p, axis=-1, keepdims=True) + jnp.exp(sink_l - m))
    o = jnp.einsum('bngrqk,bnkgd->bnqgrd', p.astype(vw.dtype), vw)
    return o.reshape(b, s, W_SWA)


def hybrid_layer(x, w_in, q_norm, kv_norm, w_uq, w_ukv, lam_vecs, subln, sink,
                 rel_bias, w_out, ln_g, ln_b, pos, lam_init):
    h = x @ w_in
    split_points = np.cumsum(IN_SIZES)[:-1].tolist()
    c_q, c_kv, k_r, dq, dk, dv, sq, sk, sv, gate = jnp.split(h, split_points, axis=-1)
    o = jnp.concatenate([
        mla_attention(c_q, c_kv, k_r, q_norm, kv_norm, w_uq, w_ukv, pos),
        diff_attention(dq, dk, dv, lam_vecs, subln, rel_bias, lam_init),
        swa_attention(sq, sk, sv, sink, rel_bias),
    ], axis=-1)
    y = (o * jax.nn.silu(gate)) @ w_out
    return layer_norm(DEEPNORM_ALPHA * x + y, ln_g, ln_b)


def setup_inputs(seed: int = 0) -> dict:
    key = jax.random.key(seed)
    ks = jax.random.split(key, 14)
    f32 = jnp.float32
    nrm = lambda k, shape, sc: jax.random.normal(k, shape, f32) * sc
    return {
        "x": nrm(ks[0], (BATCH, SEQ, D_MODEL), 1.0),
        "w_in": nrm(ks[1], (DEPTH, D_MODEL, D_IN), D_MODEL ** -0.5),
        "mla_q_norm": 1.0 + nrm(ks[2], (DEPTH, MLA_Q_RANK), 0.02),
        "mla_kv_norm": 1.0 + nrm(ks[3], (DEPTH, MLA_KV_RANK), 0.02),
        "mla_w_uq": nrm(ks[4], (DEPTH, MLA_Q_RANK, MLA_HEADS * (MLA_NOPE + MLA_ROPE)), MLA_Q_RANK ** -0.5),
        "mla_w_ukv": nrm(ks[5], (DEPTH, MLA_KV_RANK, MLA_HEADS * (MLA_NOPE + MLA_V)), MLA_KV_RANK ** -0.5),
        "diff_lambda": nrm(ks[6], (DEPTH, 4, DIFF_QK), 0.1),
        "diff_subln": 1.0 + nrm(ks[7], (DEPTH, DIFF_V), 0.02),
        "swa_sink": nrm(ks[8], (DEPTH, SWA_HEADS), 0.5),
        "rel_bias": nrm(ks[9], (REL_BUCKETS, BIAS_HEADS), 0.3),
        "w_out": nrm(ks[10], (DEPTH, D_MIX, D_MODEL), DEEPNORM_BETA * D_MIX ** -0.5),
        "ln_g": 1.0 + nrm(ks[11], (DEPTH, D_MODEL), 0.02),
        "ln_b": nrm(ks[12], (DEPTH, D_MODEL), 0.02),
    }


def reference(x, w_in, mla_q_norm, mla_kv_norm, mla_w_uq, mla_w_ukv, diff_lambda,
              diff_subln, swa_sink, rel_bias, w_out, ln_g, ln_b):
    pos = jnp.arange(x.shape[1], dtype=jnp.int32)
    for l in range(DEPTH):
        lam_init = 0.8 - 0.6 * math.exp(-0.3 * l)
        x = hybrid_layer(x, w_in[l], mla_q_norm[l], mla_kv_norm[l], mla_w_uq[l], mla_w_ukv[l],
                         diff_lambda[l], diff_subln[l], swa_sink[l], rel_bias,
                         w_out[l], ln_g[l], ln_b[l], pos, lam_init)
    return x
```

```cpp
#include <hip/hip_runtime.h>
#include <hip/hip_cooperative_groups.h>
#include <cstdio>
#include <cstdint>
namespace cg = cooperative_groups;

#ifndef MK_COOP
#define MK_COOP 1
#endif

#define DI __device__ __forceinline__
typedef unsigned short u16;
using bf16x8 = __attribute__((ext_vector_type(8))) short;
using s16x4  = __attribute__((ext_vector_type(4))) short;
using f32x16 = __attribute__((ext_vector_type(16))) float;
using f32x4  = __attribute__((ext_vector_type(4))) float;
using f32x2  = __attribute__((ext_vector_type(2))) float;
using u32x4  = __attribute__((ext_vector_type(4))) unsigned;
using u32x2  = __attribute__((ext_vector_type(2))) unsigned;
using b16x2  = __attribute__((ext_vector_type(2))) __bf16;
#define MFMA(a, b, c) __builtin_amdgcn_mfma_f32_32x32x16_bf16((a), (b), (c), 0, 0, 0)

constexpr int NB = 4, S = 8192, T = NB * S, DM = 1024, DIN = 2784, DEPTH = 4;
constexpr int C_CQ = 0, C_CKV = 192, C_KR = 320, C_DQ = 352, C_DK = 608, C_DV = 864, C_SQ = 1120, C_SK = 1504, C_SV = 1632, C_GATE = 1760;
constexpr int QW = 576, KW = 576, VW = 384;
constexpr float LOG2E = 1.4426950408889634f;
constexpr float ALPHA = 1.681792830507429f;
constexpr int NTHR = 512;
constexpr float PSLIM = 4096.0f;

constexpr size_t SZ_WIN = (size_t)DEPTH * DIN * DM * 2, SZ_WOUT = (size_t)DEPTH * DM * DM * 2;
constexpr size_t SZ_WUQ = (size_t)DEPTH * 576 * 192 * 2, SZ_WUKV = (size_t)DEPTH * 768 * 128 * 2;
constexpr size_t SZ_ROPE = (size_t)S * 16 * 8, SZ_LAM = 256;
constexpr size_t SZ_XB = (size_t)T * DM * 2, SZ_H = (size_t)T * DIN * 2, SZ_QB = (size_t)T * QW * 2, SZ_KB = (size_t)T * KW * 2;
constexpr size_t SZ_VB = (size_t)T * VW * 2, SZ_OB = (size_t)T * DM * 2, SZ_DK = (size_t)T * 256 * 2, SZ_SK = (size_t)T * 128 * 2;
constexpr size_t OFF_WIN = 0, OFF_WOUT = OFF_WIN + SZ_WIN, OFF_WUQ = OFF_WOUT + SZ_WOUT, OFF_WUKV = OFF_WUQ + SZ_WUQ;
constexpr size_t OFF_ROPE = OFF_WUKV + SZ_WUKV, OFF_LAM = OFF_ROPE + SZ_ROPE, OFF_XB = OFF_LAM + SZ_LAM, OFF_H = OFF_XB + SZ_XB;
constexpr size_t OFF_QB = OFF_H + SZ_H, OFF_KB = OFF_QB + SZ_QB, OFF_VB = OFF_KB + SZ_KB, OFF_OB = OFF_VB + SZ_VB, OFF_DK = OFF_OB + SZ_OB, OFF_DV = OFF_DK + SZ_DK, OFF_SK = OFF_DV + SZ_DK, OFF_SV = OFF_SK + SZ_SK, OFF_BAR = OFF_SV + SZ_SK, WS_END = OFF_BAR + 256;

struct Params {
  const float *x, *w_in, *qn, *kvn, *w_uq, *w_ukv, *lamv, *subln, *sink, *relb, *w_out, *ln_g, *ln_b;
  float* out;
  char* ws;
};

extern __shared__ __attribute__((aligned(16))) char lds_dyn[];
constexpr int LDS_BYTES = 147456;

DI u16 f2bf(float x) { unsigned u = __float_as_uint(x); u += 0x7fffu + ((u >> 16) & 1u); return (u16)(u >> 16); }
DI float bf2f(u16 b) { return __uint_as_float(((unsigned)b) << 16); }
DI unsigned pk2(float lo, float hi) { f32x2 v = {lo, hi}; b16x2 r = __builtin_convertvector(v, b16x2); return __builtin_bit_cast(unsigned, r); }
DI float bflo(unsigned w) { return __uint_as_float(w << 16); }
DI float bfhi(unsigned w) { return __uint_as_float(w & 0xffff0000u); }
DI int crow(int r, int hh) { return (r & 3) + 8 * (r >> 2) + 4 * hh; }
DI float xchg_max(float v) {
  auto rr = __builtin_amdgcn_permlane32_swap(__float_as_uint(v), __float_as_uint(v), false, false);
  return fmaxf(__uint_as_float(rr[0]), __uint_as_float(rr[1]));
}
DI float xchg_sum(float v) {
  auto rr = __builtin_amdgcn_permlane32_swap(__float_as_uint(v), __float_as_uint(v), false, false);
  return __uint_as_float(rr[0]) + __uint_as_float(rr[1]);
}
DI float wave_sum(float v) {
  for (int o = 32; o >= 1; o >>= 1) v += __shfl_xor(v, o);
  return v;
}
DI int t5_bucket(int rel) {
  int n = rel < 0 ? -rel : rel;
  int b;
  if (n < 8) b = n;
  else b = 8 + (n >= 12) + (n >= 16) + (n >= 23) + (n >= 32) + (n >= 46) + (n >= 64) + (n >= 91);
  return b + (rel > 0 ? 16 : 0);
}
DI bf16x8 pack8(const f32x16& x, int s8) {
  u32x4 p = {pk2(x[s8 + 0], x[s8 + 1]), pk2(x[s8 + 2], x[s8 + 3]), pk2(x[s8 + 4], x[s8 + 5]), pk2(x[s8 + 6], x[s8 + 7])};
  return __builtin_bit_cast(bf16x8, p);
}

__device__ __constant__ float ROPE_FREQ[16] = {
  1.0f, 0.5623413324356079f, 0.3162277638912201f, 0.17782793939113617f, 0.10000000149011612f, 0.05623413249850273f,
  0.03162277489900589f, 0.017782794311642647f, 0.009999999776482582f, 0.005623413249850273f, 0.003162277629598975f,
  0.0017782794311642647f, 0.0010000000474974513f, 0.000562341301701963f, 0.0003162277571391314f, 0.00017782794020604342f};

DI void prep_transpose_tile(const float* __restrict__ src, u16* __restrict__ dst, int R, int C, const float* __restrict__ g, int tr, int tc, float* lds) {
  int tid_ = threadIdx.x; asm volatile("" : "+v"(tid_)); const int tid = tid_;
  for (int i = tid; i < 4096; i += NTHR) {
    int r = i >> 6, c = i & 63, gr = tr * 64 + r, gc = tc * 64 + c;
    float v = 0.f;
    if (gr < R && gc < C) { v = src[(size_t)gr * C + gc]; if (g) v *= g[gr]; }
    lds[r * 65 + c] = v;
  }
  __syncthreads();
  for (int i = tid; i < 4096; i += NTHR) {
    int c = i >> 6, r = i & 63, gr = tr * 64 + r, gc = tc * 64 + c;
    if (gr < R && gc < C) dst[(size_t)gc * R + gr] = f2bf(lds[r * 65 + c]);
  }
  __syncthreads();
}

DI void sincos_d(double a, float& c, float& s) {
  const double TWO_PI = 6.283185307179586476925286766559, INV_TWO_PI = 0.15915494309189533576888376337251;
  double n = rint(a * INV_TWO_PI);
  double r = fma(-n, TWO_PI, a);
  r = fma(-n, 2.4492935982947064e-16, r);
  double r2 = r * r;
  double sp = 1.0 / 15511210043330985984000000.0;
  sp = fma(sp, r2, -1.0 / 25852016738884976640000.0);
  sp = fma(sp, r2, 1.0 / 51090942171709440000.0);
  sp = fma(sp, r2, -1.0 / 121645100408832000.0);
  sp = fma(sp, r2, 1.0 / 355687428096000.0);
  sp = fma(sp, r2, -1.0 / 1307674368000.0);
  sp = fma(sp, r2, 1.0 / 6227020800.0);
  sp = fma(sp, r2, -1.0 / 39916800.0);
  sp = fma(sp, r2, 1.0 / 362880.0);
  sp = fma(sp, r2, -1.0 / 5040.0);
  sp = fma(sp, r2, 1.0 / 120.0);
  sp = fma(sp, r2, -1.0 / 6.0);
  sp = fma(sp, r2, 1.0);
  double cp = 1.0 / 620448401733239439360000.0;
  cp = fma(cp, r2, -1.0 / 1124000727777607680000.0);
  cp = fma(cp, r2, 1.0 / 2432902008176640000.0);
  cp = fma(cp, r2, -1.0 / 6402373705728000.0);
  cp = fma(cp, r2, 1.0 / 20922789888000.0);
  cp = fma(cp, r2, -1.0 / 87178291200.0);
  cp = fma(cp, r2, 1.0 / 479001600.0);
  cp = fma(cp, r2, -1.0 / 3628800.0);
  cp = fma(cp, r2, 1.0 / 40320.0);
  cp = fma(cp, r2, -1.0 / 720.0);
  cp = fma(cp, r2, 1.0 / 24.0);
  cp = fma(cp, r2, -0.5);
  cp = fma(cp, r2, 1.0);
  s = (float)(sp * r); c = (float)cp;
}

DI void phase_prep(const Params& p, char* lds) {
  u16* wt_in = (u16*)(p.ws + OFF_WIN); u16* wt_out = (u16*)(p.ws + OFF_WOUT);
  u16* wt_uq = (u16*)(p.ws + OFF_WUQ); u16* wt_ukv = (u16*)(p.ws + OFF_WUKV);
  constexpr int N_IN = 16 * 44, N_OUT = 16 * 16, N_UQ = 3 * 9, N_UKV = 2 * 12;
  constexpr int PER_L = N_IN + N_OUT + N_UQ + N_UKV;
  for (int it = blockIdx.x; it < DEPTH * PER_L; it += gridDim.x) {
    int l = it / PER_L, j = it % PER_L;
    if (j < N_IN) prep_transpose_tile(p.w_in + (size_t)l * DM * DIN, wt_in + (size_t)l * DIN * DM, DM, DIN, nullptr, j / 44, j % 44, (float*)lds);
    else if ((j -= N_IN) < N_OUT) prep_transpose_tile(p.w_out + (size_t)l * DM * DM, wt_out + (size_t)l * DM * DM, DM, DM, nullptr, j / 16, j % 16, (float*)lds);
    else if ((j -= N_OUT) < N_UQ) prep_transpose_tile(p.w_uq + (size_t)l * 192 * 576, wt_uq + (size_t)l * 576 * 192, 192, 576, p.qn + l * 192, j / 9, j % 9, (float*)lds);
    else { j -= N_UQ; prep_transpose_tile(p.w_ukv + (size_t)l * 128 * 768, wt_ukv + (size_t)l * 768 * 128, 128, 768, p.kvn + l * 128, j / 12, j % 12, (float*)lds); }
  }
  const size_t gtid = (size_t)blockIdx.x * NTHR + threadIdx.x, gsz = (size_t)gridDim.x * NTHR;
  u16* xb = (u16*)(p.ws + OFF_XB);
  for (size_t i = gtid; i < (size_t)T * DM / 8; i += gsz) {
    f32x4 a = *(const f32x4*)(p.x + i * 8), b = *(const f32x4*)(p.x + i * 8 + 4);
    u32x4 o = {pk2(a[0], a[1]), pk2(a[2], a[3]), pk2(b[0], b[1]), pk2(b[2], b[3])};
    *(u32x4*)(xb + i * 8) = o;
  }
  f32x2* rt = (f32x2*)(p.ws + OFF_ROPE);
  for (size_t i = gtid; i < (size_t)S * 16; i += gsz) {
    int pos = (int)(i >> 4), k = (int)(i & 15);
    float ang = (float)pos * ROPE_FREQ[k];
    float c, s; sincos_d((double)ang, c, s);
    f32x2 v = {c, s}; rt[i] = v;
  }
  if (blockIdx.x == 0 && threadIdx.x < DEPTH) {
    int l = threadIdx.x; const float* lv = p.lamv + l * 128;
    float d1 = 0.f, d2 = 0.f;
    for (int i = 0; i < 32; ++i) { d1 += lv[i] * lv[32 + i]; d2 += lv[64 + i] * lv[96 + i]; }
    float lam_init = 0.8f - 0.6f * expf(-0.3f * (float)l);
    float* lm = (float*)(p.ws + OFF_LAM);
    lm[l] = expf(d1) - expf(d2) + lam_init;
    lm[4 + l] = 1.0f - lam_init;
  }
}

#define LDS_BARRIER() asm volatile("s_waitcnt lgkmcnt(0)\n\ts_barrier" ::: "memory")
DI void gemm256(const u16* __restrict__ A, int lda, const u16* __restrict__ Bt, int ldb, int m0, int n0, int nvalid, int K,
                char* lds, f32x16 (&acc)[4][2], const float* cinit = nullptr) {
  constexpr int ASZ = 256 * 144, STG = 2 * ASZ;
  int tid_ = threadIdx.x; asm volatile("" : "+v"(tid_)); const int tid = tid_, lane = tid & 63, w = tid >> 6, l32 = lane & 31, hh = lane >> 5, wm = w & 1, wn = w >> 1;
  if (cinit) {
    const float* cp = cinit + (size_t)(m0 + 128 * wm + 4 * hh) * DM + (n0 + 64 * wn + l32);
#pragma unroll
    for (int mi = 0; mi < 4; ++mi)
#pragma unroll
      for (int ni = 0; ni < 2; ++ni)
#pragma unroll
        for (int r = 0; r < 16; ++r) acc[mi][ni][r] = ALPHA * cp[(32 * mi + (r & 3) + 8 * (r >> 2)) * DM + 32 * ni];
  } else {
#pragma unroll
    for (int mi = 0; mi < 4; ++mi)
#pragma unroll
      for (int ni = 0; ni < 2; ++ni)
#pragma unroll
        for (int r = 0; r < 16; ++r) acc[mi][ni][r] = 0.f;
  }
  u32x4 ra[4], rb[4];
  const int KT = K / 64;
  const int lrow = tid >> 3, lch = tid & 7;
  const u16* ap = A + (size_t)(m0 + lrow) * lda + lch * 8;
  const u16* bp = Bt + (size_t)(n0 + lrow) * ldb + lch * 8;
  auto gload = [&](int kt) {
#pragma unroll
    for (int i = 0; i < 4; ++i) ra[i] = *(const u32x4*)(ap + (size_t)(64 * i) * lda + kt * 64);
#pragma unroll
    for (int i = 0; i < 4; ++i) { u32x4 z = {0u, 0u, 0u, 0u};
      rb[i] = (lrow + 64 * i < nvalid) ? *(const u32x4*)(bp + (size_t)(64 * i) * ldb + kt * 64) : z; }
  };
  auto lstore = [&](int st) {
    char* As = lds + st * STG + lrow * 144 + lch * 16;
#pragma unroll
    for (int i = 0; i < 4; ++i) *(u32x4*)(As + 64 * i * 144) = ra[i];
#pragma unroll
    for (int i = 0; i < 4; ++i) *(u32x4*)(As + ASZ + 64 * i * 144) = rb[i];
  };
  auto compute = [&](int st) {
    const char* As = lds + st * STG + (128 * wm + l32) * 144 + hh * 16;
    const char* Bs = lds + st * STG + ASZ + (64 * wn + l32) * 144 + hh * 16;
    bf16x8 a0[4], b0[2], a1[4], b1[2];
#define LDFRAG(K16, AF, BF) do { _Pragma("unroll") for (int mi = 0; mi < 4; ++mi) AF[mi] = *(const bf16x8*)(As + 32 * mi * 144 + (K16) * 32); \
    _Pragma("unroll") for (int ni = 0; ni < 2; ++ni) BF[ni] = *(const bf16x8*)(Bs + 32 * ni * 144 + (K16) * 32); } while (0)
#define MMSTEP(AF, BF) do { _Pragma("unroll") for (int mi = 0; mi < 4; ++mi) _Pragma("unroll") for (int ni = 0; ni < 2; ++ni) acc[mi][ni] = MFMA(AF[mi], BF[ni], acc[mi][ni]); } while (0)
#define SGB(mask, n) __builtin_amdgcn_sched_group_barrier(mask, n, 0)
#define PIPE_STEP() do { SGB(0x100, 1); SGB(0x008, 1); SGB(0x100, 1); SGB(0x008, 1); SGB(0x100, 1); SGB(0x008, 1); SGB(0x100, 1); SGB(0x008, 1); \
    SGB(0x100, 1); SGB(0x008, 1); SGB(0x100, 1); SGB(0x008, 1); SGB(0x008, 2); } while (0)
    LDFRAG(0, a0, b0);
    LDFRAG(1, a1, b1); MMSTEP(a0, b0);
    LDFRAG(2, a0, b0); MMSTEP(a1, b1);
    LDFRAG(3, a1, b1); MMSTEP(a0, b0);
    MMSTEP(a1, b1);
    __builtin_amdgcn_iglp_opt(1);
#undef LDFRAG
#undef MMSTEP
#undef PIPE_STEP
  };
  gload(0); lstore(0);
  LDS_BARRIER();
  for (int kt = 0; kt < KT; ++kt) {
    if (kt + 1 < KT) gload(kt + 1);
    compute(kt & 1);
    if (kt + 1 < KT) lstore((kt + 1) & 1);
    LDS_BARRIER();
  }
}

DI int g8_lds_byte(int r, int c) { int st = (r >> 4) * 2 + (c >> 5), rr = r & 15, cc = c & 31, ob = rr * 64 + cc * 2; return st * 1024 + (ob ^ (((ob >> 9) & 1) << 5)); }
DI void g8_stage_rc(int b, int& R, int& C) { int st = b / 1024, sb = b % 1024, swz = sb ^ (((sb >> 9) & 1) << 5); R = (st >> 1) * 16 + swz / 64; C = (st & 1) * 32 + (swz % 64) / 2; }
DI void gemm8p(const u16* __restrict__ A, const u16* __restrict__ Bt, int brow, int bcol, f32x4 (&acc)[2][2][4][2]) {
  constexpr int K = 1024, BK = 64, HALF = 128, HT = HALF * BK;
  u16* shm = (u16*)lds_dyn;
#define G8_SA(b, h) (shm + ((b) * 2 + (h)) * HT)
#define G8_SB(b, h) (shm + (4 + (b) * 2 + (h)) * HT)
#define G8_STAGE(P, BASE, br, kt) do { const u16* gb_ = (BASE) + ((long)(br) * K + (long)(kt) * BK);     \
      __builtin_amdgcn_global_load_lds((const unsigned*)(gb_ + soff0), (__attribute__((address_space(3))) unsigned*)((char*)(P) + tid8 * 16), 16, 0, 0); \
      __builtin_amdgcn_global_load_lds((const unsigned*)(gb_ + soff1), (__attribute__((address_space(3))) unsigned*)((char*)(P) + tid8 * 16 + 8192), 16, 0, 0); } while (0)
#define G8_LDA(dst, b, h) for (int m = 0; m < 4; ++m) for (int k = 0; k < 2; ++k) \
    dst[m][k] = *reinterpret_cast<const bf16x8*>((char*)G8_SA(b, h) + g8_lds_byte(wr * 64 + m * 16 + fr, k * 32 + fq * 8))
#define G8_LDB(dst, b, h) for (int n = 0; n < 2; ++n) for (int k = 0; k < 2; ++k) \
    dst[n][k] = *reinterpret_cast<const bf16x8*>((char*)G8_SB(b, h) + g8_lds_byte(wc * 32 + n * 16 + fr, k * 32 + fq * 8))
#define G8_MMA(ai, bj, At_, Bt_) do { __builtin_amdgcn_s_setprio(1); \
    for (int m = 0; m < 4; ++m) for (int n = 0; n < 2; ++n) for (int k = 0; k < 2; ++k) \
      acc[ai][bj][m][n] = __builtin_amdgcn_mfma_f32_16x16x32_bf16(At_[m][k], Bt_[n][k], acc[ai][bj][m][n], 0, 0, 0); \
    __builtin_amdgcn_s_setprio(0); } while (0)
#define G8_WV(n) asm volatile("s_waitcnt vmcnt(" #n ")" ::: "memory")
#define G8_WL(n) asm volatile("s_waitcnt lgkmcnt(" #n ")" ::: "memory")
#define G8_BAR __builtin_amdgcn_s_barrier()
#define G8_SCHED __builtin_amdgcn_sched_barrier(0)
  int tid8 = threadIdx.x; asm volatile("" : "+v"(tid8));
  const int wid = tid8 >> 6, lane = tid8 & 63, wr = wid >> 2, wc = wid & 3, fr = lane & 15, fq = lane >> 4;
  int soff0, soff1;
  { int r_, c_; g8_stage_rc(tid8 * 16, r_, c_); soff0 = r_ * K + c_; g8_stage_rc(tid8 * 16 + 8192, r_, c_); soff1 = r_ * K + c_; }
  bf16x8 At[4][2], B0[2][2], B1[2][2];
  constexpr int nt = K / BK;
  __syncthreads();
  G8_STAGE(G8_SB(0, 0), Bt, bcol, 0); G8_STAGE(G8_SA(0, 0), A, brow, 0);
  G8_STAGE(G8_SB(0, 1), Bt, bcol + HALF, 0); G8_STAGE(G8_SA(0, 1), A, brow + HALF, 0);
  if (wr == 1) G8_BAR;
  G8_WV(4); G8_BAR;
  G8_STAGE(G8_SB(1, 0), Bt, bcol, 1); G8_STAGE(G8_SA(1, 0), A, brow, 1); G8_STAGE(G8_SB(1, 1), Bt, bcol + HALF, 1);
  G8_WV(6); G8_BAR;
#pragma unroll 1
  for (int t = 0; t < nt - 2; t += 2) {
    G8_LDB(B0, 0, 0); G8_SCHED; G8_LDA(At, 0, 0); G8_STAGE(G8_SA(1, 1), A, brow + HALF, t + 1);
    G8_WL(8); G8_BAR; G8_WL(0); G8_MMA(0, 0, At, B0); G8_BAR; G8_SCHED;
    G8_LDB(B1, 0, 1); G8_STAGE(G8_SB(0, 0), Bt, bcol, t + 2);
    G8_BAR; G8_WL(0); G8_MMA(0, 1, At, B1); G8_BAR;
    G8_LDA(At, 0, 1); G8_STAGE(G8_SA(0, 0), A, brow, t + 2);
    G8_BAR; G8_WL(0); G8_MMA(1, 0, At, B0); G8_BAR; G8_SCHED;
    G8_STAGE(G8_SB(0, 1), Bt, bcol + HALF, t + 2);
    G8_WV(6); G8_BAR; G8_MMA(1, 1, At, B1); G8_BAR;
    G8_LDB(B0, 1, 0); G8_SCHED; G8_LDA(At, 1, 0); G8_STAGE(G8_SA(0, 1), A, brow + HALF, t + 2);
    G8_WL(8); G8_BAR; G8_WL(0); G8_MMA(0, 0, At, B0); G8_BAR; G8_SCHED;
    G8_LDB(B1, 1, 1); G8_STAGE(G8_SB(1, 0), Bt, bcol, t + 3);
    G8_BAR; G8_WL(0); G8_MMA(0, 1, At, B1); G8_BAR;
    G8_LDA(At, 1, 1); G8_STAGE(G8_SA(1, 0), A, brow, t + 3);
    G8_BAR; G8_WL(0); G8_MMA(1, 0, At, B0); G8_BAR; G8_SCHED;
    G8_STAGE(G8_SB(1, 1), Bt, bcol + HALF, t + 3);
    G8_WV(6); G8_BAR; G8_MMA(1, 1, At, B1); G8_BAR;
  }
  { G8_LDB(B0, 0, 0); G8_LDA(At, 0, 0); G8_STAGE(G8_SA(1, 1), A, brow + HALF, nt - 1);
    G8_BAR; G8_WL(0); G8_MMA(0, 0, At, B0); G8_BAR;
    G8_LDB(B1, 0, 1); G8_BAR; G8_WL(0); G8_MMA(0, 1, At, B1); G8_BAR;
    G8_LDA(At, 0, 1); G8_WV(4); G8_BAR; G8_WL(0); G8_MMA(1, 0, At, B0); G8_MMA(1, 1, At, B1); G8_BAR; }
  { G8_LDB(B0, 1, 0); G8_LDA(At, 1, 0); G8_WV(2); G8_BAR; G8_WL(0); G8_MMA(0, 0, At, B0); G8_BAR;
    G8_LDB(B1, 1, 1); G8_WV(0); G8_BAR; G8_WL(0); G8_MMA(0, 1, At, B1); G8_BAR;
    G8_LDA(At, 1, 1); G8_BAR; G8_WL(0); G8_MMA(1, 0, At, B0); G8_MMA(1, 1, At, B1); G8_BAR; }
  if (wr == 0) G8_BAR;
#undef G8_SA
#undef G8_SB
#undef G8_STAGE
#undef G8_LDA
#undef G8_LDB
#undef G8_MMA
#undef G8_WV
#undef G8_WL
#undef G8_BAR
#undef G8_SCHED
}

DI void phase_inproj(const Params& p, int layer, char* lds) {
  const u16* xb = (const u16*)(p.ws + OFF_XB);
  const u16* wt = (const u16*)(p.ws + OFF_WIN) + (size_t)layer * DIN * DM;
  u16* H = (u16*)(p.ws + OFF_H);
  int tid_ = threadIdx.x; asm volatile("" : "+v"(tid_)); const int tid = tid_, lane = tid & 63, w = tid >> 6, l32 = lane & 31, hh = lane >> 5, wm = w & 1, wn = w >> 1;
  constexpr int NTN = 11, NRB = T / 256, NTILES = NRB * NTN;
  const float SC_DQ = 0.17677669529663687f * LOG2E, SC_SQ = 0.125f * LOG2E;
  const bool xcd_ok = (gridDim.x % 8) == 0;
  const int xj = xcd_ok ? (int)(blockIdx.x & 7) : 0, nbl = xcd_ok ? (int)(gridDim.x >> 3) : (int)gridDim.x;
  const int bl = xcd_ok ? (int)(blockIdx.x >> 3) : (int)blockIdx.x, per_x = xcd_ok ? NTILES / 8 : NTILES;
  for (int u = bl; u < per_x; u += nbl) {
    const int lr = u / NTN, nt = u % NTN;
    const int mt = xcd_ok ? lr * 8 + xj : lr, m0 = mt * 256, n0 = nt * 256;
    const int nvalid = (DIN - n0) < 256 ? (DIN - n0) : 256;
    (void)nvalid;
    f32x4 acc[2][2][4][2];
#pragma unroll
    for (int ai = 0; ai < 2; ++ai)
#pragma unroll
      for (int bj = 0; bj < 2; ++bj)
#pragma unroll
        for (int m = 0; m < 4; ++m)
#pragma unroll
          for (int n = 0; n < 2; ++n) acc[ai][bj][m][n] = (f32x4){0.f, 0.f, 0.f, 0.f};
    gemm8p(xb, wt, m0, n0, acc);
    const int wr8 = w >> 2, wc8 = w & 3, fr = lane & 15, fq = lane >> 4;
#pragma unroll
    for (int bj = 0; bj < 2; ++bj)
#pragma unroll
      for (int n = 0; n < 2; ++n) {
        const int cw = n0 + bj * 128 + wc8 * 32 + n * 16, col = cw + fr;
        u16* dst = H + cw; int dstr = DIN;
        {
          const int bb = m0 / S;
          if (cw >= C_DK && cw < C_DV) { const int o = cw - C_DK; dst = (u16*)(p.ws + OFF_DK) + ((size_t)(bb * 3 * S + (o >> 6) * S) << 6) + (o & 63); dstr = 64; }
          else if (cw >= C_DV && cw < C_SQ) { const int o = cw - C_DV; dst = (u16*)(p.ws + OFF_DV) + ((size_t)(bb * 3 * S + (o >> 6) * S) << 6) + (o & 63); dstr = 64; }
          else if (cw >= C_SK && cw < C_SV) { const int o = cw - C_SK; dst = (u16*)(p.ws + OFF_SK) + ((size_t)(bb * 1 * S + (o >> 6) * S) << 6) + (o & 63); dstr = 64; }
          else if (cw >= C_SV && cw < C_GATE) { const int o = cw - C_SV; dst = (u16*)(p.ws + OFF_SV) + ((size_t)(bb * 1 * S + (o >> 6) * S) << 6) + (o & 63); dstr = 64; }
        }
        if (cw < DIN) {
          float sc = 1.f;
          if (col >= C_DQ && col < C_DK) sc = SC_DQ;
          if (col >= C_SQ && col < C_SK) sc = SC_SQ;
          const bool gate = col >= C_GATE;
#pragma unroll
          for (int ai = 0; ai < 2; ++ai)
#pragma unroll
            for (int m = 0; m < 4; ++m) {
#pragma unroll
              for (int j = 0; j < 4; ++j) {
                const int row = m0 + ai * 128 + wr8 * 64 + m * 16 + fq * 4 + j;
                float v = acc[ai][bj][m][n][j] * sc;
                if (gate) v = v * __builtin_amdgcn_rcpf(1.f + __expf(-v));
                dst[(size_t)row * dstr + fr] = f2bf(v);
              }
              __builtin_amdgcn_sched_barrier(0);
            }
        }
      }
  }
}

DI void phase_mla_up(const Params& p, int layer, char* lds) {
  const u16* H = (const u16*)(p.ws + OFF_H);
  const u16* wuq = (const u16*)(p.ws + OFF_WUQ) + (size_t)layer * 576 * 192;
  const u16* wukv = (const u16*)(p.ws + OFF_WUKV) + (size_t)layer * 768 * 128;
  const f32x2* rt = (const f32x2*)(p.ws + OFF_ROPE);
  u16* QB = (u16*)(p.ws + OFF_QB); u16* KB = (u16*)(p.ws + OFF_KB); u16* VB = (u16*)(p.ws + OFF_VB);
  int tid_ = threadIdx.x; asm volatile("" : "+v"(tid_)); const int tid = tid_, lane = tid & 63, w = tid >> 6, l32 = lane & 31, hh = lane >> 5, wm = w & 3, wn = w >> 2;
  char* As = lds; char* Bs = lds + 128 * 400; float* rinv = (float*)(lds + 256 * 400);
  const float QSC = 0.10206207261596577f * LOG2E;
  for (int item = blockIdx.x; item < T / 128; item += gridDim.x) {
    const int m0 = item * 128;
#pragma unroll 1
    for (int part = 0; part < 2; ++part) {
      const int K = part == 0 ? 192 : 128, acol = part == 0 ? C_CQ : C_CKV, STR = (K + 8) * 2, CPR = K / 8;
      const int NCT = part == 0 ? 9 : 12;
      const u16* Wt = part == 0 ? wuq : wukv;
      __syncthreads();
      for (int c = tid; c < 128 * CPR; c += NTHR) { int row = c / CPR, ch = c % CPR;
        *(u32x4*)(As + row * STR + ch * 16) = *(const u32x4*)(H + (size_t)(m0 + row) * DIN + acol + ch * 8); }
      __syncthreads();
      {
        int row = tid >> 2, part4 = tid & 3, n = K / 4; float ss = 0.f;
        const u16* ar = (const u16*)(As + row * STR) + part4 * n;
        for (int i = 0; i < n; ++i) { float v = bf2f(ar[i]); ss += v * v; }
        ss += __shfl_xor(ss, 1); ss += __shfl_xor(ss, 2);
        if (part4 == 0) rinv[row] = rsqrtf(ss / (float)K + 1e-6f);
      }
      const int NCT2 = (NCT + 1) / 2, NOUT = NCT * 64;
      u32x4 rw[6];
      auto wload = [&](int ct) {
        int tl = tid; asm volatile("" : "+v"(tl));
#pragma unroll
        for (int i = 0; i < 6; ++i) { const int c = tl + NTHR * i; if (c < 128 * CPR) rw[i] = *(const u32x4*)(Wt + (size_t)ct * 128 * K + c * 8); }
      };
      auto epi = [&](const f32x16& acc, const int c0) {
        const int col = c0 + l32;
        if (part == 0) {
          const bool is_rope = (c0 % 96 == 64);
#pragma unroll
          for (int r = 0; r < 16; ++r) {
            const int lrow = 32 * wm + crow(r, hh), trow = m0 + lrow;
            float v = acc[r] * rinv[lrow] * QSC;
            if (is_rope) {
              float o = __shfl_xor(v, 16);
              f32x2 cs = rt[(size_t)(trow & (S - 1)) * 16 + (l32 & 15)];
              v = (l32 < 16) ? (v * cs[0] - o * cs[1]) : (v * cs[0] + o * cs[1]);
            }
            QB[(size_t)trow * QW + col] = f2bf(v);
          }
        } else {
          const int head = c0 >> 7, within = c0 & 127;
#pragma unroll
          for (int r = 0; r < 16; ++r) {
            const int lrow = 32 * wm + crow(r, hh), trow = m0 + lrow;
            float v = acc[r] * rinv[lrow];
            const size_t hrow = (size_t)((trow >> 13) * 6 + head) * S + (trow & (S - 1));
            if (within < 64) KB[hrow * 96 + within + l32] = f2bf(v);
            else VB[hrow * 64 + (within - 64) + l32] = f2bf(v);
          }
        }
      };
      wload(0);
#pragma unroll 1
      for (int ct = 0; ct < NCT2; ++ct) {
        {
          int tl = tid; asm volatile("" : "+v"(tl));
#pragma unroll
          for (int i = 0; i < 6; ++i) { const int c = tl + NTHR * i, row = c / CPR, ch = c % CPR; if (c < 128 * CPR) *(u32x4*)(Bs + row * STR + ch * 16) = rw[i]; }
        }
        LDS_BARRIER();
        if (ct + 1 < NCT2) wload(ct + 1);
        f32x16 acc0, acc1;
#pragma unroll
        for (int r = 0; r < 16; ++r) { acc0[r] = 0.f; acc1[r] = 0.f; }
        for (int st = 0; st < K / 16; ++st) {
          bf16x8 af = *(const bf16x8*)(As + (32 * wm + l32) * STR + (16 * st + 8 * hh) * 2);
          bf16x8 b0 = *(const bf16x8*)(Bs + (64 * wn + l32) * STR + (16 * st + 8 * hh) * 2);
          bf16x8 b1 = *(const bf16x8*)(Bs + (64 * wn + 32 + l32) * STR + (16 * st + 8 * hh) * 2);
          acc0 = MFMA(af, b0, acc0);
          acc1 = MFMA(af, b1, acc1);
        }
        const int c0 = ct * 128 + 64 * wn;
        if (c0 < NOUT) epi(acc0, c0);
        if (c0 + 32 < NOUT) epi(acc1, c0 + 32);
        LDS_BARRIER();
      }
    }
    for (int idx = tid; idx < 128 * 16; idx += NTHR) {
      const int row = idx >> 4, i = idx & 15, trow = m0 + row;
      float x1 = bf2f(H[(size_t)trow * DIN + C_KR + i]), x2 = bf2f(H[(size_t)trow * DIN + C_KR + 16 + i]);
      f32x2 cs = rt[(size_t)(trow & (S - 1)) * 16 + i];
      u16 o1 = f2bf(x1 * cs[0] - x2 * cs[1]), o2 = f2bf(x2 * cs[0] + x1 * cs[1]);
#pragma unroll
      for (int hd = 0; hd < 6; ++hd) { const size_t hrow = (size_t)((trow >> 13) * 6 + hd) * S + (trow & (S - 1)); KB[hrow * 96 + 64 + i] = o1; KB[hrow * 96 + 80 + i] = o2; }
    }
  }
}

constexpr int VSTR = 192;
template <int OFF>
DI void trread8(unsigned addr, s16x4 (&v)[8]) {
  asm volatile(
      "ds_read_b64_tr_b16 %0, %8 offset:%9\n\t"
      "ds_read_b64_tr_b16 %1, %8 offset:%10\n\t"
      "ds_read_b64_tr_b16 %2, %8 offset:%11\n\t"
      "ds_read_b64_tr_b16 %3, %8 offset:%12\n\t"
      "ds_read_b64_tr_b16 %4, %8 offset:%13\n\t"
      "ds_read_b64_tr_b16 %5, %8 offset:%14\n\t"
      "ds_read_b64_tr_b16 %6, %8 offset:%15\n\t"
      "ds_read_b64_tr_b16 %7, %8 offset:%16\n\t"
      "s_waitcnt lgkmcnt(0)"
      : "=&v"(v[0]), "=&v"(v[1]), "=&v"(v[2]), "=&v"(v[3]), "=&v"(v[4]), "=&v"(v[5]), "=&v"(v[6]), "=&v"(v[7])
      : "v"(addr), "i"(OFF + 0 * VSTR + 0), "i"(OFF + 8 * VSTR + 0), "i"(OFF + 0 * VSTR + 64), "i"(OFF + 8 * VSTR + 64),
        "i"(OFF + 16 * VSTR + 0), "i"(OFF + 24 * VSTR + 0), "i"(OFF + 16 * VSTR + 64), "i"(OFF + 24 * VSTR + 64)
      : "memory");
}

template <int MODE>
DI void attn_item(const Params& p, int layer, int bh, int qb, char* lds) {
  constexpr int KD = MODE == 0 ? 96 : 64, NMAP = MODE == 1 ? 2 : 1, QS = MODE == 0 ? 6 : (MODE == 1 ? 2 : 4);
  constexpr int KSTR = KD * 2 + 16, KBYTES = 64 * KSTR, VBYTES = 64 * VSTR, STAGE = KBYTES + VBYTES, KCH = (8 * KD + NTHR - 1) / NTHR, KCPR = KD / 8, KCHUNKS = 8 * KD;
  constexpr int BREL_BYTES = 2048;
  int tid_ = threadIdx.x; asm volatile("" : "+v"(tid_)); const int tid = tid_, lane = tid & 63, w = tid >> 6, l32 = lane & 31, hh = lane >> 5;
  const int q0 = qb * 256, q0w = q0 + 32 * w;
  const u16 *Qg, *Kg, *Vg; int qstr, kstr, vstr, ocol, b, hd;
  if (MODE == 0) {
    b = bh / 6; hd = bh % 6;
    Qg = (const u16*)(p.ws + OFF_QB) + (size_t)b * S * QW + hd * 96; qstr = QW;
    Kg = (const u16*)(p.ws + OFF_KB) + (size_t)(b * 6 + hd) * S * 96; kstr = 96;
    Vg = (const u16*)(p.ws + OFF_VB) + (size_t)(b * 6 + hd) * S * 64; vstr = 64;
    ocol = hd * 64;
  } else if (MODE == 1) {
    b = bh / 4; hd = bh % 4;
    const u16* Hb = (const u16*)(p.ws + OFF_H) + (size_t)b * S * DIN;
    Qg = Hb + C_DQ + hd * 64; qstr = DIN; kstr = vstr = 64;
    Kg = (const u16*)(p.ws + OFF_DK) + (size_t)(b * 4 + hd) * S * 64; Vg = (const u16*)(p.ws + OFF_DV) + (size_t)(b * 4 + hd) * S * 64;
    ocol = 384 + hd * 64;
  } else {
    b = bh / 6; hd = bh % 6;
    const u16* Hb = (const u16*)(p.ws + OFF_H) + (size_t)b * S * DIN;
    Qg = Hb + C_SQ + hd * 64; qstr = DIN; kstr = vstr = 64;
    Kg = (const u16*)(p.ws + OFF_SK) + (size_t)(b * 2 + hd / 3) * S * 64; Vg = (const u16*)(p.ws + OFF_SV) + (size_t)(b * 2 + hd / 3) * S * 64;
    ocol = 640 + hd * 64;
  }
  float* brel = (float*)lds;
  char* stage0 = lds + BREL_BYTES;
  if (MODE != 0) {
    const int bcol = MODE == 1 ? hd : 4 + hd;
    for (int i = tid; i < 512; i += NTHR) {
      int rel = i - 224, rc = rel < -128 ? -128 : (rel > 128 ? 128 : rel);
      float bv = p.relb[t5_bucket(rc) * 10 + bcol] * LOG2E;
      brel[i] = (MODE == 2 && rc != rel) ? -1e30f : bv;
    }
  }
  bf16x8 qf[NMAP][QS];
  {
    const u16* qrow = Qg + (size_t)(q0w + l32) * qstr + hh * 8;
#pragma unroll
    for (int mp = 0; mp < NMAP; ++mp)
#pragma unroll
      for (int st = 0; st < QS; ++st) qf[mp][st] = *(const bf16x8*)(qrow + (mp * QS + st) * 16);
  }
  f32x16 O[NMAP][2]; float m = 0.f, l[NMAP];
#pragma unroll
  for (int mp = 0; mp < NMAP; ++mp) {
#pragma unroll
    for (int r = 0; r < 16; ++r) { O[mp][0][r] = 0.f; O[mp][1][r] = 0.f; }
    l[mp] = 0.f;
  }
  if (MODE == 2) { m = p.sink[layer * 6 + hd] * LOG2E; l[0] = (hh == 0) ? 1.f : 0.f; }
  int kt0 = 0, kt1 = S / 64;
  if (MODE == 2) { kt0 = (q0 - 128) / 64; if (kt0 < 0) kt0 = 0; kt1 = (q0 + 384) / 64; if (kt1 > S / 64) kt1 = S / 64; }
  const int nt = kt1 - kt0;
  constexpr int KSTRG = MODE == 0 ? 96 : 64, VSTRG = 64;
  u32x4 rkA[KCH], rvA[1], rkB[KCH], rvB[1];
  auto gload = [&](int kt, u32x4 (&rk)[KCH], u32x4 (&rv)[1]) {
    const u16* kb = Kg + (size_t)kt * (64 * KSTRG);
    const u16* vb = Vg + (size_t)kt * (64 * VSTRG);
#pragma unroll
    for (int i = 0; i < KCH; ++i) if (tid + NTHR * i < KCHUNKS) rk[i] = *(const u32x4*)(kb + tid * 8 + NTHR * 8 * i);
    rv[0] = *(const u32x4*)(vb + tid * 8);
  };
  auto lstore = [&](int st, const u32x4 (&rk)[KCH], const u32x4 (&rv)[1]) {
    char* Ks = stage0 + st * STAGE;
#pragma unroll
    for (int i = 0; i < KCH; ++i) { int c = tid + NTHR * i, row = c / KCPR, ch = c % KCPR; if (c < KCHUNKS) *(u32x4*)(Ks + row * KSTR + ch * 16) = rk[i]; }
    { int row = tid >> 3, ch = tid & 7; *(u32x4*)(Ks + KBYTES + row * VSTR + ch * 16) = rv[0]; }
  };
  const unsigned vlane = (unsigned)((4 * hh + ((lane & 15) >> 2)) * VSTR + 32 * ((lane >> 4) & 1) + 8 * (lane & 3));
  bf16x8 kaug, qaug;
  { u32x4 tk = {hh == 0 ? 0x3F803F80u : 0u, 0u, 0u, 0u}; kaug = __builtin_bit_cast(bf16x8, tk); qaug = __builtin_bit_cast(bf16x8, (u32x4){0u, 0u, 0u, 0u}); }
  f32x16 c0p;
  auto set_c0 = [&](float c0) {
    const unsigned hi = f2bf(c0); const unsigned lo = f2bf(c0 - bf2f((u16)hi));
    u32x4 tq = {hh == 0 ? (hi | (lo << 16)) : 0u, 0u, 0u, 0u}; qaug = __builtin_bit_cast(bf16x8, tq);
    if (NMAP == 1) { const f32x16 z16 = {0.f, 0.f, 0.f, 0.f, 0.f, 0.f, 0.f, 0.f, 0.f, 0.f, 0.f, 0.f, 0.f, 0.f, 0.f, 0.f}; c0p = MFMA(kaug, qaug, z16); }
  };
  int c0cls = -1;
  auto compute = [&](const int t, const int cur) {
    const int k0 = (kt0 + t) * 64;
    const char* Ks = stage0 + cur * STAGE;
    bool active = true;
    if (MODE == 2) active = (k0 + 63 >= q0w - 128) && (k0 <= q0w + 159);
    if (active) {
      const float* brow = brel + (k0 - q0w - l32 + 4 * hh + 224);
      int cls = 0; float cb = 0.f;
      if (MODE == 1) {
        const int rmax = k0 + 63 - q0w, rmin = k0 - (q0w + 31);
        if (rmax <= -128) { cls = 1; cb = brel[224 - 128]; }
        else if (rmin >= 128) { cls = 2; cb = brel[224 + 128]; }
      }
      const bool far = cls != 0;
      if (cls != c0cls) { c0cls = cls; set_c0(cb - m); }
      const unsigned vaddr = (unsigned)(uintptr_t)(Ks + KBYTES) + vlane;
      typedef __attribute__((address_space(3))) s16x4 lds_s16x4;
      s16x4 vpre[16];
      u32x4 pk[NMAP][2][2];
#pragma unroll
      for (int mp = 0; mp < NMAP; ++mp) {
        f32x16 s[2];
        const f32x16 zero16 = {0.f, 0.f, 0.f, 0.f, 0.f, 0.f, 0.f, 0.f, 0.f, 0.f, 0.f, 0.f, 0.f, 0.f, 0.f, 0.f};
        __builtin_amdgcn_s_setprio(1);
        f32x16 c0tile;
        if (NMAP == 1) c0tile = c0p; else c0tile = MFMA(kaug, qaug, zero16);
#pragma unroll
        for (int sub = 0; sub < 2; ++sub) {
#pragma unroll
          for (int st = 0; st < QS; ++st) {
            bf16x8 kf = *(const bf16x8*)(Ks + (32 * sub + l32) * KSTR + ((mp * QS + st) * 16 + hh * 8) * 2);
            if (st == 0) s[sub] = MFMA(kf, qf[mp][st], c0tile); else s[sub] = MFMA(kf, qf[mp][st], s[sub]);
          }
        }
        __builtin_amdgcn_iglp_opt(1);
        __builtin_amdgcn_s_setprio(0);
        if (NMAP == 1) {
          lds_s16x4* vb = (lds_s16x4*)(Ks + KBYTES + vlane);
#pragma unroll
          for (int i = 0; i < 16; ++i) {
            const int sub_ = i >> 3, ks_ = (i >> 2) & 1, dt_ = (i >> 1) & 1, g_ = i & 1;
            vpre[i] = __builtin_amdgcn_ds_read_tr16_b64_v4i16(vb + ((32 * sub_ + 16 * ks_ + 8 * g_) * VSTR + 64 * dt_) / 8);
          }
          __builtin_amdgcn_sched_barrier(0);
        }
        if (MODE != 0 && !far) {
#pragma unroll
          for (int sub = 0; sub < 2; ++sub)
#pragma unroll
            for (int r = 0; r < 16; ++r) s[sub][r] += brow[32 * sub + (r & 3) + 8 * (r >> 2)];
        }
        const bool first = (MODE != 2) && (t == 0) && (mp == 0);
        auto rebase = [&]() {
          float mx = fmaxf(fmaxf(s[0][0], s[0][1]), s[0][2]);
#pragma unroll
          for (int r = 3; r < 15; r += 2) mx = fmaxf(fmaxf(mx, s[0][r]), s[0][r + 1]);
          mx = fmaxf(mx, s[0][15]);
#pragma unroll
          for (int r = 0; r < 16; r += 2) mx = fmaxf(fmaxf(mx, s[1][r]), s[1][r + 1]);
          const float rm = xchg_max(mx);
          float delta = first ? rm : fmaxf(rm, 0.f);
          if (delta < -1e29f) delta = 0.f;
          m += delta;
          const float alpha = __builtin_amdgcn_exp2f(-delta);
#pragma unroll
          for (int mq = 0; mq < NMAP; ++mq) {
            l[mq] *= alpha;
#pragma unroll
            for (int r = 0; r < 16; ++r) { O[mq][0][r] *= alpha; O[mq][1][r] *= alpha; }
          }
#pragma unroll
          for (int r = 0; r < 16; ++r) { s[0][r] -= delta; s[1][r] -= delta; }
          set_c0(cb - m);
        };
        float ps;
        auto smpass = [&]() {
          ps = 0.f;
#pragma unroll
          for (int sub = 0; sub < 2; ++sub)
#pragma unroll
            for (int ks = 0; ks < 2; ++ks)
#pragma unroll
              for (int i = 0; i < 4; ++i) {
                const float p0 = __builtin_amdgcn_exp2f(s[sub][8 * ks + 2 * i]), p1 = __builtin_amdgcn_exp2f(s[sub][8 * ks + 2 * i + 1]);
                ps += p0 + p1; pk[mp][sub][ks][i] = pk2(p0, p1);
              }
        };
        if (first) rebase();
        smpass();
        if (!first && __any(!(ps <= PSLIM))) { rebase(); smpass(); }
        l[mp] += ps;
        __builtin_amdgcn_sched_barrier(0);
      }
#pragma unroll
      for (int sub = 0; sub < 2; ++sub) {
        s16x4 vv[8];
        if (NMAP == 1) {
#pragma unroll
          for (int i = 0; i < 8; ++i) vv[i] = vpre[sub * 8 + i];
        } else {
          if (sub == 0) trread8<0>(vaddr, vv); else trread8<32 * VSTR>(vaddr, vv);
        }
        __builtin_amdgcn_s_setprio(1);
#pragma unroll
        for (int ks = 0; ks < 2; ++ks) {
#pragma unroll
          for (int dt = 0; dt < 2; ++dt) {
            s16x4 lo = vv[ks * 4 + dt * 2], hi = vv[ks * 4 + dt * 2 + 1];
            bf16x8 vf = __builtin_shufflevector(lo, hi, 0, 1, 2, 3, 4, 5, 6, 7);
#pragma unroll
            for (int mp = 0; mp < NMAP; ++mp) O[mp][dt] = MFMA(vf, __builtin_bit_cast(bf16x8, pk[mp][sub][ks]), O[mp][dt]);
          }
        }
        __builtin_amdgcn_s_setprio(0);
        __builtin_amdgcn_sched_barrier(0);
      }
    }
  };
  __syncthreads();
  gload(kt0, rkA, rvA); lstore(0, rkA, rvA);
  if (nt > 1) gload(kt0 + 1, rkB, rvB);
  LDS_BARRIER();
  for (int t = 0; t < nt; t += 2) {
    if (t + 2 < nt) gload(kt0 + t + 2, rkA, rvA);
    compute(t, 0);
    if (t + 1 < nt) lstore(1, rkB, rvB);
    LDS_BARRIER();
    if (t + 1 >= nt) break;
    if (t + 3 < nt) gload(kt0 + t + 3, rkB, rvB);
    compute(t + 1, 1);
    if (t + 2 < nt) lstore(0, rkA, rvA);
    LDS_BARRIER();
  }
  __syncthreads();
  const size_t trow = (size_t)b * S + q0w + l32;
  const u16* grow = (const u16*)(p.ws + OFF_H) + trow * DIN + C_GATE + ocol;
  u16* orow = (u16*)(p.ws + OFF_OB) + trow * DM + ocol;
  float inv0 = 1.f / xchg_sum(l[0]);
  if (MODE == 1) {
    const float* lm = (const float*)(p.ws + OFF_LAM);
    const float lam = lm[layer], post = lm[4 + layer];
    const float inv1 = lam / xchg_sum(l[1]);
    float ss = 0.f;
#pragma unroll
    for (int dt = 0; dt < 2; ++dt)
#pragma unroll
      for (int r = 0; r < 16; ++r) { float v = O[0][dt][r] * inv0 - O[NMAP - 1][dt][r] * inv1; O[0][dt][r] = v; ss += v * v; }
    ss = xchg_sum(ss);
    inv0 = rsqrtf(ss * (1.f / 64.f) + 1e-6f) * post;
  }
#pragma unroll
  for (int dt = 0; dt < 2; ++dt)
#pragma unroll
    for (int g = 0; g < 4; ++g) {
      const int d = 32 * dt + 8 * g + 4 * hh;
      u32x2 gw = *(const u32x2*)(grow + d);
      float v0 = O[0][dt][4 * g + 0] * inv0, v1 = O[0][dt][4 * g + 1] * inv0, v2 = O[0][dt][4 * g + 2] * inv0, v3 = O[0][dt][4 * g + 3] * inv0;
      if (MODE == 1) { const float* sl = p.subln + layer * 64 + d; v0 *= sl[0]; v1 *= sl[1]; v2 *= sl[2]; v3 *= sl[3]; }
      v0 *= bflo(gw[0]); v1 *= bfhi(gw[0]); v2 *= bflo(gw[1]); v3 *= bfhi(gw[1]);
      u32x2 ow = {pk2(v0, v1), pk2(v2, v3)};
#ifdef PROBE_ZERO_MODE
      if (MODE == PROBE_ZERO_MODE) { ow[0] = 0u; ow[1] = 0u; }
#endif
      *(u32x2*)(orow + d) = ow;
    }
}

DI void phase_attn(const Params& p, int layer, char* lds) {
  constexpr int N_MLA = 24 * 32, N_DIFF = 16 * 32, N_SWA = 24 * 32;
  for (int g = blockIdx.x; g < N_MLA + N_DIFF + N_SWA; g += gridDim.x) {
    if (g < N_MLA) { int i = g; attn_item<0>(p, layer, (i & 7) + 8 * (i >> 8), (i >> 3) & 31, lds); }
    else if (g < N_MLA + N_DIFF) { int i = g - N_MLA; attn_item<1>(p, layer, (i & 7) + 8 * (i >> 8), (i >> 3) & 31, lds); }
    else { int i = g - N_MLA - N_DIFF; attn_item<2>(p, layer, (i & 7) + 8 * (i >> 8), (i >> 3) & 31, lds); }
  }
}

DI void phase_outproj(const Params& p, int layer, char* lds) {
  const u16* ob = (const u16*)(p.ws + OFF_OB);
  const u16* wt = (const u16*)(p.ws + OFF_WOUT) + (size_t)layer * DM * DM;
  const float* xres = layer == 0 ? p.x : p.out;
  float* xout = p.out;
  int tid_ = threadIdx.x; asm volatile("" : "+v"(tid_)); const int tid = tid_, lane = tid & 63, w = tid >> 6, l32 = lane & 31, hh = lane >> 5, wm = w & 1, wn = w >> 1;
  constexpr int NTN = DM / 256, NRB = T / 256, NTILES = NRB * NTN;
  const bool xcd_ok = (gridDim.x % 8) == 0;
  const int xj = xcd_ok ? (int)(blockIdx.x & 7) : 0, nbl = xcd_ok ? (int)(gridDim.x >> 3) : (int)gridDim.x;
  const int bl = xcd_ok ? (int)(blockIdx.x >> 3) : (int)blockIdx.x, per_x = xcd_ok ? NTILES / 8 : NTILES;
  for (int u = bl; u < per_x; u += nbl) {
    const int lr = u / NTN, nt = u % NTN, mt = xcd_ok ? lr * 8 + xj : lr, m0 = mt * 256, n0 = nt * 256;
    const int wr8 = w >> 2, wc8 = w & 3, fr = lane & 15, fq = lane >> 4;
    const size_t base = (size_t)(m0 + wr8 * 64 + fq * 4) * DM + (n0 + wc8 * 32 + fr);
    f32x4 acc[2][2][4][2];
#pragma unroll
    for (int ai = 0; ai < 2; ++ai)
#pragma unroll
      for (int bj = 0; bj < 2; ++bj)
#pragma unroll
        for (int m = 0; m < 4; ++m)
#pragma unroll
          for (int n = 0; n < 2; ++n) acc[ai][bj][m][n] = (f32x4){0.f, 0.f, 0.f, 0.f};
    gemm8p(ob, wt, m0, n0, acc);
    u16* yo = (u16*)(p.ws + OFF_XB) + base;
#pragma unroll
    for (int ai = 0; ai < 2; ++ai)
#pragma unroll
      for (int bj = 0; bj < 2; ++bj)
#pragma unroll
        for (int m = 0; m < 4; ++m) {
#pragma unroll
          for (int n = 0; n < 2; ++n)
#pragma unroll
            for (int j = 0; j < 4; ++j) yo[(ai * 128 + m * 16 + j) * DM + bj * 128 + n * 16] = f2bf(acc[ai][bj][m][n][j]);
          __builtin_amdgcn_sched_barrier(0);
        }
  }
}

DI void phase_ln(const Params& p, int layer) {
  const float* xres = layer == 0 ? p.x : p.out;
  float* xout = p.out;
  u16* xb = (u16*)(p.ws + OFF_XB);
  const float* lg = p.ln_g + layer * DM; const float* lb = p.ln_b + layer * DM;
  int tid_ = threadIdx.x; asm volatile("" : "+v"(tid_)); const int tid = tid_, lane = tid & 63, w = tid >> 6;
#pragma unroll 1
  for (size_t row = (size_t)blockIdx.x * 8 + w; row < (size_t)T; row += (size_t)gridDim.x * 8) {
    f32x4 v[4]; float sum = 0.f;
#pragma unroll
    for (int i = 0; i < 4; ++i) {
      const f32x4 xv = *(const f32x4*)(xres + row * DM + 4 * lane + 256 * i);
      const u32x2 yw = *(const u32x2*)(xb + row * DM + 4 * lane + 256 * i);
      v[i][0] = ALPHA * xv[0] + bflo(yw[0]); v[i][1] = ALPHA * xv[1] + bfhi(yw[0]); v[i][2] = ALPHA * xv[2] + bflo(yw[1]); v[i][3] = ALPHA * xv[3] + bfhi(yw[1]);
      sum += v[i][0] + v[i][1] + v[i][2] + v[i][3];
    }
    const float mu = wave_sum(sum) * (1.f / DM);
    float sq = 0.f;
#pragma unroll
    for (int i = 0; i < 4; ++i)
#pragma unroll
      for (int j = 0; j < 4; ++j) { float d = v[i][j] - mu; sq += d * d; }
    const float rstd = rsqrtf(wave_sum(sq) * (1.f / DM) + 1e-5f);
#pragma unroll
    for (int i = 0; i < 4; ++i) {
      const int col = 4 * lane + 256 * i;
      f32x4 g = *(const f32x4*)(lg + col), bb = *(const f32x4*)(lb + col), o;
#pragma unroll
      for (int j = 0; j < 4; ++j) o[j] = (v[i][j] - mu) * rstd * g[j] + bb[j];
      *(f32x4*)(xout + row * DM + col) = o;
      if (layer + 1 < DEPTH) {
        u32x2 ow = {pk2(o[0], o[1]), pk2(o[2], o[3])};
        *(u32x2*)(xb + row * DM + col) = ow;
      }
    }
  }
}

#if MK_COOP
DI void fast_grid_sync(unsigned* ctr, unsigned& epoch) {
  asm volatile("s_waitcnt vmcnt(0) lgkmcnt(0)" ::: "memory");
  __syncthreads();
  epoch += 1u;
  if (threadIdx.x == 0) {
    __builtin_amdgcn_fence(__ATOMIC_RELEASE, "agent");
    asm volatile("s_waitcnt vmcnt(0)" ::: "memory");
    const unsigned target = epoch * gridDim.x;
    (void)__hip_atomic_fetch_add(ctr, 1u, __ATOMIC_RELAXED, __HIP_MEMORY_SCOPE_AGENT);
    unsigned spins = 0;
    while (__hip_atomic_load(ctr, __ATOMIC_RELAXED, __HIP_MEMORY_SCOPE_AGENT) < target) {
      __builtin_amdgcn_s_sleep(2);
      if (++spins > (1u << 26)) break;
    }
    __builtin_amdgcn_fence(__ATOMIC_ACQUIRE, "agent");
    asm volatile("s_waitcnt vmcnt(0)" ::: "memory");
  }
  __syncthreads();
}

__global__ void __launch_bounds__(NTHR) fwd_megakernel(Params p) {
  char* lds = lds_dyn;
  cg::grid_group grid = cg::this_grid();
  unsigned* bar_ctr = (unsigned*)(p.ws + OFF_BAR); unsigned bar_epoch = 0;
  phase_prep(p, lds);
  grid.sync();
  for (int layer = 0; layer < DEPTH; ++layer) {
    phase_inproj(p, layer, lds);
    fast_grid_sync(bar_ctr, bar_epoch);
    phase_mla_up(p, layer, lds);
    fast_grid_sync(bar_ctr, bar_epoch);
#ifdef PROBE_REP_P12
    phase_inproj(p, layer, lds);
    fast_grid_sync(bar_ctr, bar_epoch);
    phase_mla_up(p, layer, lds);
    fast_grid_sync(bar_ctr, bar_epoch);
#endif
#ifdef PROBE_REP_P2
    phase_mla_up(p, layer, lds);
    fast_grid_sync(bar_ctr, bar_epoch);
#endif
    phase_attn(p, layer, lds);
#ifdef PROBE_REP_ATTN
    fast_grid_sync(bar_ctr, bar_epoch);
    phase_attn(p, layer, lds);
#endif
    fast_grid_sync(bar_ctr, bar_epoch);
    phase_outproj(p, layer, lds);
    fast_grid_sync(bar_ctr, bar_epoch);
    phase_ln(p, layer);
    if (layer + 1 < DEPTH) fast_grid_sync(bar_ctr, bar_epoch);
  }
}
#else
template <int PH>
__global__ void __launch_bounds__(NTHR, 2) phase_kernel(Params p, int layer) {
  __shared__ __attribute__((aligned(16))) char lds[LDS_BYTES];
  if (PH == 0) phase_prep(p, lds);
  if (PH == 1) phase_inproj(p, layer, lds);
  if (PH == 2) phase_mla_up(p, layer, lds);
  if (PH == 3) phase_attn(p, layer, lds);
  if (PH == 4) phase_outproj(p, layer, lds);
  if (PH == 5) phase_ln(p, layer);
}
#endif

extern "C" void kernel_launch(void* const* d_in, const int* in_sizes, int n_in, void* d_out, int out_size, void* d_ws, size_t ws_size,
                              hipStream_t stream) {
  if (n_in != 13 || ws_size < WS_END || out_size != T * DM) {
    fprintf(stderr, "kernel_launch: unexpected shapes n_in %d ws %zu (need %zu) out %d\n", n_in, ws_size, WS_END, out_size);
    return;
  }
  Params p{};
  p.x = (const float*)d_in[0]; p.w_in = (const float*)d_in[1]; p.qn = (const float*)d_in[2]; p.kvn = (const float*)d_in[3];
  p.w_uq = (const float*)d_in[4]; p.w_ukv = (const float*)d_in[5]; p.lamv = (const float*)d_in[6]; p.subln = (const float*)d_in[7];
  p.sink = (const float*)d_in[8]; p.relb = (const float*)d_in[9]; p.w_out = (const float*)d_in[10]; p.ln_g = (const float*)d_in[11];
  p.ln_b = (const float*)d_in[12]; p.out = (float*)d_out; p.ws = (char*)d_ws;
#if MK_COOP
  static int grid_blocks = 0;
  if (!grid_blocks) {
    int dev = 0, cus = 0, per_cu = 0;
    hipGetDevice(&dev);
    hipDeviceGetAttribute(&cus, hipDeviceAttributeMultiprocessorCount, dev);
    if (hipFuncSetAttribute((const void*)fwd_megakernel, hipFuncAttributeMaxDynamicSharedMemorySize, LDS_BYTES) != hipSuccess)
      fprintf(stderr, "kernel_launch: hipFuncSetAttribute(%d B dynamic LDS) failed\n", LDS_BYTES);
    hipOccupancyMaxActiveBlocksPerMultiprocessor(&per_cu, fwd_megakernel, NTHR, LDS_BYTES);
    (void)hipGetLastError();
    (void)per_cu;
    grid_blocks = cus;
  }
  (void)hipMemsetAsync((char*)d_ws + OFF_BAR, 0, 256, stream);
  void* args[] = {&p};
  hipError_t e = hipLaunchCooperativeKernel((void*)fwd_megakernel, dim3(grid_blocks), dim3(NTHR), args, LDS_BYTES, stream);
  if (e != hipSuccess) fprintf(stderr, "cooperative launch failed: %s (grid %d)\n", hipGetErrorString(e), grid_blocks);
#else
  const int G = 512;
  hipLaunchKernelGGL(phase_kernel<0>, dim3(G), dim3(NTHR), 0, stream, p, 0);
  for (int l = 0; l < DEPTH; ++l) {
    hipLaunchKernelGGL(phase_kernel<1>, dim3(G), dim3(NTHR), 0, stream, p, l);
    hipLaunchKernelGGL(phase_kernel<2>, dim3(G), dim3(NTHR), 0, stream, p, l);
    hipLaunchKernelGGL(phase_kernel<3>, dim3(G), dim3(NTHR), 0, stream, p, l);
    hipLaunchKernelGGL(phase_kernel<4>, dim3(G), dim3(NTHR), 0, stream, p, l);
    hipLaunchKernelGGL(phase_kernel<5>, dim3(G), dim3(NTHR), 0, stream, p, l);
  }
#endif
}
```

```cpp
#include <hip/hip_runtime.h>
#include <hip/hip_cooperative_groups.h>
#include <cstdio>
#include <cstdint>
namespace cg = cooperative_groups;

#ifndef MK_COOP
#define MK_COOP 1
#endif

#define DI __device__ __forceinline__
typedef unsigned short u16;
using bf16x8 = __attribute__((ext_vector_type(8))) short;
using s16x4  = __attribute__((ext_vector_type(4))) short;
using f32x16 = __attribute__((ext_vector_type(16))) float;
using f32x4  = __attribute__((ext_vector_type(4))) float;
using f32x2  = __attribute__((ext_vector_type(2))) float;
using u32x4  = __attribute__((ext_vector_type(4))) unsigned;
using u32x2  = __attribute__((ext_vector_type(2))) unsigned;
using b16x2  = __attribute__((ext_vector_type(2))) __bf16;
#define MFMA(a, b, c) __builtin_amdgcn_mfma_f32_32x32x16_bf16((a), (b), (c), 0, 0, 0)

constexpr int NB = 4, S = 8192, T = NB * S, DM = 1024, DIN = 2784, DEPTH = 4;
constexpr int C_CQ = 0, C_CKV = 192, C_KR = 320, C_DQ = 352, C_DK = 608, C_DV = 864, C_SQ = 1120, C_SK = 1504, C_SV = 1632, C_GATE = 1760;
constexpr int QW = 576, KW = 576, VW = 384;
constexpr float LOG2E = 1.4426950408889634f;
constexpr float ALPHA = 1.681792830507429f;
constexpr int NTHR = 512;
constexpr float PSLIM = 4096.0f;

constexpr size_t SZ_WIN = (size_t)DEPTH * DIN * DM * 2, SZ_WOUT = (size_t)DEPTH * DM * DM * 2;
constexpr size_t SZ_WUQ = (size_t)DEPTH * 576 * 192 * 2, SZ_WUKV = (size_t)DEPTH * 768 * 128 * 2;
constexpr size_t SZ_ROPE = (size_t)S * 16 * 8, SZ_LAM = 256;
constexpr size_t SZ_XB = (size_t)T * DM * 2, SZ_H = (size_t)T * DIN * 2, SZ_QB = (size_t)T * QW * 2, SZ_KB = (size_t)T * KW * 2;
constexpr size_t SZ_VB = (size_t)T * VW * 2, SZ_OB = (size_t)T * DM * 2, SZ_DK = (size_t)T * 256 * 2, SZ_SK = (size_t)T * 128 * 2;
constexpr size_t OFF_WIN = 0, OFF_WOUT = OFF_WIN + SZ_WIN, OFF_WUQ = OFF_WOUT + SZ_WOUT, OFF_WUKV = OFF_WUQ + SZ_WUQ;
constexpr size_t OFF_ROPE = OFF_WUKV + SZ_WUKV, OFF_LAM = OFF_ROPE + SZ_ROPE, OFF_XB = OFF_LAM + SZ_LAM, OFF_H = OFF_XB + SZ_XB;
constexpr size_t OFF_QB = OFF_H + SZ_H, OFF_KB = OFF_QB + SZ_QB, OFF_VB = OFF_KB + SZ_KB, OFF_OB = OFF_VB + SZ_VB, OFF_DK = OFF_OB + SZ_OB, OFF_DV = OFF_DK + SZ_DK, OFF_SK = OFF_DV + SZ_DK, OFF_SV = OFF_SK + SZ_SK, OFF_BAR = OFF_SV + SZ_SK, WS_END = OFF_BAR + 256;

struct Params {
  const float *x, *w_in, *qn, *kvn, *w_uq, *w_ukv, *lamv, *subln, *sink, *relb, *w_out, *ln_g, *ln_b;
  float* out;
  char* ws;
};

extern __shared__ __attribute__((aligned(16))) char lds_dyn[];
constexpr int LDS_BYTES = 147456;

DI u16 f2bf(float x) { unsigned u = __float_as_uint(x); u += 0x7fffu + ((u >> 16) & 1u); return (u16)(u >> 16); }
DI float bf2f(u16 b) { return __uint_as_float(((unsigned)b) << 16); }
DI unsigned pk2(float lo, float hi) { f32x2 v = {lo, hi}; b16x2 r = __builtin_convertvector(v, b16x2); return __builtin_bit_cast(unsigned, r); }
DI float bflo(unsigned w) { return __uint_as_float(w << 16); }
DI float bfhi(unsigned w) { return __uint_as_float(w & 0xffff0000u); }
DI int crow(int r, int hh) { return (r & 3) + 8 * (r >> 2) + 4 * hh; }
DI float xchg_max(float v) {
  auto rr = __builtin_amdgcn_permlane32_swap(__float_as_uint(v), __float_as_uint(v), false, false);
  return fmaxf(__uint_as_float(rr[0]), __uint_as_float(rr[1]));
}
DI float xchg_sum(float v) {
  auto rr = __builtin_amdgcn_permlane32_swap(__float_as_uint(v), __float_as_uint(v), false, false);
  return __uint_as_float(rr[0]) + __uint_as_float(rr[1]);
}
DI float wave_sum(float v) {
  for (int o = 32; o >= 1; o >>= 1) v += __shfl_xor(v, o);
  return v;
}
DI int t5_bucket(int rel) {
  int n = rel < 0 ? -rel : rel;
  int b;
  if (n < 8) b = n;
  else b = 8 + (n >= 12) + (n >= 16) + (n >= 23) + (n >= 32) + (n >= 46) + (n >= 64) + (n >= 91);
  return b + (rel > 0 ? 16 : 0);
}
DI bf16x8 pack8(const f32x16& x, int s8) {
  u32x4 p = {pk2(x[s8 + 0], x[s8 + 1]), pk2(x[s8 + 2], x[s8 + 3]), pk2(x[s8 + 4], x[s8 + 5]), pk2(x[s8 + 6], x[s8 + 7])};
  return __builtin_bit_cast(bf16x8, p);
}

__device__ __constant__ float ROPE_FREQ[16] = {
  1.0f, 0.5623413324356079f, 0.3162277638912201f, 0.17782793939113617f, 0.10000000149011612f, 0.05623413249850273f,
  0.03162277489900589f, 0.017782794311642647f, 0.009999999776482582f, 0.005623413249850273f, 0.003162277629598975f,
  0.0017782794311642647f, 0.0010000000474974513f, 0.000562341301701963f, 0.0003162277571391314f, 0.00017782794020604342f};

DI void prep_transpose_tile(const float* __restrict__ src, u16* __restrict__ dst, int R, int C, const float* __restrict__ g, int tr, int tc, float* lds) {
  int tid_ = threadIdx.x; asm volatile("" : "+v"(tid_)); const int tid = tid_;
  for (int i = tid; i < 4096; i += NTHR) {
    int r = i >> 6, c = i & 63, gr = tr * 64 + r, gc = tc * 64 + c;
    float v = 0.f;
    if (gr < R && gc < C) { v = src[(size_t)gr * C + gc]; if (g) v *= g[gr]; }
    lds[r * 65 + c] = v;
  }
  __syncthreads();
  for (int i = tid; i < 4096; i += NTHR) {
    int c = i >> 6, r = i & 63, gr = tr * 64 + r, gc = tc * 64 + c;
    if (gr < R && gc < C) dst[(size_t)gc * R + gr] = f2bf(lds[r * 65 + c]);
  }
  __syncthreads();
}

DI void sincos_d(double a, float& c, float& s) {
  const double TWO_PI = 6.283185307179586476925286766559, INV_TWO_PI = 0.15915494309189533576888376337251;
  double n = rint(a * INV_TWO_PI);
  double r = fma(-n, TWO_PI, a);
  r = fma(-n, 2.4492935982947064e-16, r);
  double r2 = r * r;
  double sp = 1.0 / 15511210043330985984000000.0;
  sp = fma(sp, r2, -1.0 / 25852016738884976640000.0);
  sp = fma(sp, r2, 1.0 / 51090942171709440000.0);
  sp = fma(sp, r2, -1.0 / 121645100408832000.0);
  sp = fma(sp, r2, 1.0 / 355687428096000.0);
  sp = fma(sp, r2, -1.0 / 1307674368000.0);
  sp = fma(sp, r2, 1.0 / 6227020800.0);
  sp = fma(sp, r2, -1.0 / 39916800.0);
  sp = fma(sp, r2, 1.0 / 362880.0);
  sp = fma(sp, r2, -1.0 / 5040.0);
  sp = fma(sp, r2, 1.0 / 120.0);
  sp = fma(sp, r2, -1.0 / 6.0);
  sp = fma(sp, r2, 1.0);
  double cp = 1.0 / 620448401733239439360000.0;
  cp = fma(cp, r2, -1.0 / 1124000727777607680000.0);
  cp = fma(cp, r2, 1.0 / 2432902008176640000.0);
  cp = fma(cp, r2, -1.0 / 6402373705728000.0);
  cp = fma(cp, r2, 1.0 / 20922789888000.0);
  cp = fma(cp, r2, -1.0 / 87178291200.0);
  cp = fma(cp, r2, 1.0 / 479001600.0);
  cp = fma(cp, r2, -1.0 / 3628800.0);
  cp = fma(cp, r2, 1.0 / 40320.0);
  cp = fma(cp, r2, -1.0 / 720.0);
  cp = fma(cp, r2, 1.0 / 24.0);
  cp = fma(cp, r2, -0.5);
  cp = fma(cp, r2, 1.0);
  s = (float)(sp * r); c = (float)cp;
}

DI void phase_prep(const Params& p, char* lds) {
  u16* wt_in = (u16*)(p.ws + OFF_WIN); u16* wt_out = (u16*)(p.ws + OFF_WOUT);
  u16* wt_uq = (u16*)(p.ws + OFF_WUQ); u16* wt_ukv = (u16*)(p.ws + OFF_WUKV);
  constexpr int N_IN = 16 * 44, N_OUT = 16 * 16, N_UQ = 3 * 9, N_UKV = 2 * 12;
  constexpr int PER_L = N_IN + N_OUT + N_UQ + N_UKV;
  for (int it = blockIdx.x; it < DEPTH * PER_L; it += gridDim.x) {
    int l = it / PER_L, j = it % PER_L;
    if (j < N_IN) prep_transpose_tile(p.w_in + (size_t)l * DM * DIN, wt_in + (size_t)l * DIN * DM, DM, DIN, nullptr, j / 44, j % 44, (float*)lds);
    else if ((j -= N_IN) < N_OUT) prep_transpose_tile(p.w_out + (size_t)l * DM * DM, wt_out + (size_t)l * DM * DM, DM, DM, nullptr, j / 16, j % 16, (float*)lds);
    else if ((j -= N_OUT) < N_UQ) prep_transpose_tile(p.w_uq + (size_t)l * 192 * 576, wt_uq + (size_t)l * 576 * 192, 192, 576, p.qn + l * 192, j / 9, j % 9, (float*)lds);
    else { j -= N_UQ; prep_transpose_tile(p.w_ukv + (size_t)l * 128 * 768, wt_ukv + (size_t)l * 768 * 128, 128, 768, p.kvn + l * 128, j / 12, j % 12, (float*)lds); }
  }
  const size_t gtid = (size_t)blockIdx.x * NTHR + threadIdx.x, gsz = (size_t)gridDim.x * NTHR;
  u16* xb = (u16*)(p.ws + OFF_XB);
  for (size_t i = gtid; i < (size_t)T * DM / 8; i += gsz) {
    f32x4 a = *(const f32x4*)(p.x + i * 8), b = *(const f32x4*)(p.x + i * 8 + 4);
    u32x4 o = {pk2(a[0], a[1]), pk2(a[2], a[3]), pk2(b[0], b[1]), pk2(b[2], b[3])};
    *(u32x4*)(xb + i * 8) = o;
  }
  f32x2* rt = (f32x2*)(p.ws + OFF_ROPE);
  for (size_t i = gtid; i < (size_t)S * 16; i += gsz) {
    int pos = (int)(i >> 4), k = (int)(i & 15);
    float ang = (float)pos * ROPE_FREQ[k];
    float c, s; sincos_d((double)ang, c, s);
    f32x2 v = {c, s}; rt[i] = v;
  }
  if (blockIdx.x == 0 && threadIdx.x < DEPTH) {
    int l = threadIdx.x; const float* lv = p.lamv + l * 128;
    float d1 = 0.f, d2 = 0.f;
    for (int i = 0; i < 32; ++i) { d1 += lv[i] * lv[32 + i]; d2 += lv[64 + i] * lv[96 + i]; }
    float lam_init = 0.8f - 0.6f * expf(-0.3f * (float)l);
    float* lm = (float*)(p.ws + OFF_LAM);
    lm[l] = expf(d1) - expf(d2) + lam_init;
    lm[4 + l] = 1.0f - lam_init;
  }
}

#define LDS_BARRIER() asm volatile("s_waitcnt lgkmcnt(0)\n\ts_barrier" ::: "memory")
DI void gemm256(const u16* __restrict__ A, int lda, const u16* __restrict__ Bt, int ldb, int m0, int n0, int nvalid, int K,
                char* lds, f32x16 (&acc)[4][2], const float* cinit = nullptr) {
  constexpr int ASZ = 256 * 144, STG = 2 * ASZ;
  int tid_ = threadIdx.x; asm volatile("" : "+v"(tid_)); const int tid = tid_, lane = tid & 63, w = tid >> 6, l32 = lane & 31, hh = lane >> 5, wm = w & 1, wn = w >> 1;
  if (cinit) {
    const float* cp = cinit + (size_t)(m0 + 128 * wm + 4 * hh) * DM + (n0 + 64 * wn + l32);
#pragma unroll
    for (int mi = 0; mi < 4; ++mi)
#pragma unroll
      for (int ni = 0; ni < 2; ++ni)
#pragma unroll
        for (int r = 0; r < 16; ++r) acc[mi][ni][r] = ALPHA * cp[(32 * mi + (r & 3) + 8 * (r >> 2)) * DM + 32 * ni];
  } else {
#pragma unroll
    for (int mi = 0; mi < 4; ++mi)
#pragma unroll
      for (int ni = 0; ni < 2; ++ni)
#pragma unroll
        for (int r = 0; r < 16; ++r) acc[mi][ni][r] = 0.f;
  }
  u32x4 ra[4], rb[4];
  const int KT = K / 64;
  const int lrow = tid >> 3, lch = tid & 7;
  const u16* ap = A + (size_t)(m0 + lrow) * lda + lch * 8;
  const u16* bp = Bt + (size_t)(n0 + lrow) * ldb + lch * 8;
  auto gload = [&](int kt) {
#pragma unroll
    for (int i = 0; i < 4; ++i) ra[i] = *(const u32x4*)(ap + (size_t)(64 * i) * lda + kt * 64);
#pragma unroll
    for (int i = 0; i < 4; ++i) { u32x4 z = {0u, 0u, 0u, 0u};
      rb[i] = (lrow + 64 * i < nvalid) ? *(const u32x4*)(bp + (size_t)(64 * i) * ldb + kt * 64) : z; }
  };
  auto lstore = [&](int st) {
    char* As = lds + st * STG + lrow * 144 + lch * 16;
#pragma unroll
    for (int i = 0; i < 4; ++i) *(u32x4*)(As + 64 * i * 144) = ra[i];
#pragma unroll
    for (int i = 0; i < 4; ++i) *(u32x4*)(As + ASZ + 64 * i * 144) = rb[i];
  };
  auto compute = [&](int st) {
    const char* As = lds + st * STG + (128 * wm + l32) * 144 + hh * 16;
    const char* Bs = lds + st * STG + ASZ + (64 * wn + l32) * 144 + hh * 16;
    bf16x8 a0[4], b0[2], a1[4], b1[2];
#define LDFRAG(K16, AF, BF) do { _Pragma("unroll") for (int mi = 0; mi < 4; ++mi) AF[mi] = *(const bf16x8*)(As + 32 * mi * 144 + (K16) * 32); \
    _Pragma("unroll") for (int ni = 0; ni < 2; ++ni) BF[ni] = *(const bf16x8*)(Bs + 32 * ni * 144 + (K16) * 32); } while (0)
#define MMSTEP(AF, BF) do { _Pragma("unroll") for (int mi = 0; mi < 4; ++mi) _Pragma("unroll") for (int ni = 0; ni < 2; ++ni) acc[mi][ni] = MFMA(AF[mi], BF[ni], acc[mi][ni]); } while (0)
#define SGB(mask, n) __builtin_amdgcn_sched_group_barrier(mask, n, 0)
#define PIPE_STEP() do { SGB(0x100, 1); SGB(0x008, 1); SGB(0x100, 1); SGB(0x008, 1); SGB(0x100, 1); SGB(0x008, 1); SGB(0x100, 1); SGB(0x008, 1); \
    SGB(0x100, 1); SGB(0x008, 1); SGB(0x100, 1); SGB(0x008, 1); SGB(0x008, 2); } while (0)
    LDFRAG(0, a0, b0);
    LDFRAG(1, a1, b1); MMSTEP(a0, b0);
    LDFRAG(2, a0, b0); MMSTEP(a1, b1);
    LDFRAG(3, a1, b1); MMSTEP(a0, b0);
    MMSTEP(a1, b1);
    __builtin_amdgcn_iglp_opt(1);
#undef LDFRAG
#undef MMSTEP
#undef PIPE_STEP
  };
  gload(0); lstore(0);
  LDS_BARRIER();
  for (int kt = 0; kt < KT; ++kt) {
    if (kt + 1 < KT) gload(kt + 1);
    compute(kt & 1);
    if (kt + 1 < KT) lstore((kt + 1) & 1);
    LDS_BARRIER();
  }
}

DI int g8_lds_byte(int r, int c) { int st = (r >> 4) * 2 + (c >> 5), rr = r & 15, cc = c & 31, ob = rr * 64 + cc * 2; return st * 1024 + (ob ^ (((ob >> 9) & 1) << 5)); }
DI void g8_stage_rc(int b, int& R, int& C) { int st = b / 1024, sb = b % 1024, swz = sb ^ (((sb >> 9) & 1) << 5); R = (st >> 1) * 16 + swz / 64; C = (st & 1) * 32 + (swz % 64) / 2; }
DI void gemm8p(const u16* __restrict__ A, const u16* __restrict__ Bt, int brow, int bcol, f32x4 (&acc)[2][2][4][2]) {
  constexpr int K = 1024, BK = 64, HALF = 128, HT = HALF * BK;
  u16* shm = (u16*)lds_dyn;
#define G8_SA(b, h) (shm + ((b) * 2 + (h)) * HT)
#define G8_SB(b, h) (shm + (4 + (b) * 2 + (h)) * HT)
#define G8_STAGE(P, BASE, br, kt) do { const u16* gb_ = (BASE) + ((long)(br) * K + (long)(kt) * BK);     \
      __builtin_amdgcn_global_load_lds((const unsigned*)(gb_ + soff0), (__attribute__((address_space(3))) unsigned*)((char*)(P) + tid8 * 16), 16, 0, 0); \
      __builtin_amdgcn_global_load_lds((const unsigned*)(gb_ + soff1), (__attribute__((address_space(3))) unsigned*)((char*)(P) + tid8 * 16 + 8192), 16, 0, 0); } while (0)
#define G8_LDA(dst, b, h) for (int m = 0; m < 4; ++m) for (int k = 0; k < 2; ++k) \
    dst[m][k] = *reinterpret_cast<const bf16x8*>((char*)G8_SA(b, h) + g8_lds_byte(wr * 64 + m * 16 + fr, k * 32 + fq * 8))
#define G8_LDB(dst, b, h) for (int n = 0; n < 2; ++n) for (int k = 0; k < 2; ++k) \
    dst[n][k] = *reinterpret_cast<const bf16x8*>((char*)G8_SB(b, h) + g8_lds_byte(wc * 32 + n * 16 + fr, k * 32 + fq * 8))
#define G8_MMA(ai, bj, At_, Bt_) do { __builtin_amdgcn_s_setprio(1); \
    for (int m = 0; m < 4; ++m) for (int n = 0; n < 2; ++n) for (int k = 0; k < 2; ++k) \
      acc[ai][bj][m][n] = __builtin_amdgcn_mfma_f32_16x16x32_bf16(At_[m][k], Bt_[n][k], acc[ai][bj][m][n], 0, 0, 0); \
    __builtin_amdgcn_s_setprio(0); } while (0)
#define G8_WV(n) asm volatile("s_waitcnt vmcnt(" #n ")" ::: "memory")
#define G8_WL(n) asm volatile("s_waitcnt lgkmcnt(" #n ")" ::: "memory")
#define G8_BAR __builtin_amdgcn_s_barrier()
#define G8_SCHED __builtin_amdgcn_sched_barrier(0)
  int tid8 = threadIdx.x; asm volatile("" : "+v"(tid8));
  const int wid = tid8 >> 6, lane = tid8 & 63, wr = wid >> 2, wc = wid & 3, fr = lane & 15, fq = lane >> 4;
  int soff0, soff1;
  { int r_, c_; g8_stage_rc(tid8 * 16, r_, c_); soff0 = r_ * K + c_; g8_stage_rc(tid8 * 16 + 8192, r_, c_); soff1 = r_ * K + c_; }
  bf16x8 At[4][2], B0[2][2], B1[2][2];
  constexpr int nt = K / BK;
  __syncthreads();
  G8_STAGE(G8_SB(0, 0), Bt, bcol, 0); G8_STAGE(G8_SA(0, 0), A, brow, 0);
  G8_STAGE(G8_SB(0, 1), Bt, bcol + HALF, 0); G8_STAGE(G8_SA(0, 1), A, brow + HALF, 0);
  if (wr == 1) G8_BAR;
  G8_WV(4); G8_BAR;
  G8_STAGE(G8_SB(1, 0), Bt, bcol, 1); G8_STAGE(G8_SA(1, 0), A, brow, 1); G8_STAGE(G8_SB(1, 1), Bt, bcol + HALF, 1);
  G8_WV(6); G8_BAR;
#pragma unroll 1
  for (int t = 0; t < nt - 2; t += 2) {
    G8_LDB(B0, 0, 0); G8_SCHED; G8_LDA(At, 0, 0); G8_STAGE(G8_SA(1, 1), A, brow + HALF, t + 1);
    G8_WL(8); G8_BAR; G8_WL(0); G8_MMA(0, 0, At, B0); G8_BAR; G8_SCHED;
    G8_LDB(B1, 0, 1); G8_STAGE(G8_SB(0, 0), Bt, bcol, t + 2);
    G8_BAR; G8_WL(0); G8_MMA(0, 1, At, B1); G8_BAR;
    G8_LDA(At, 0, 1); G8_STAGE(G8_SA(0, 0), A, brow, t + 2);
    G8_BAR; G8_WL(0); G8_MMA(1, 0, At, B0); G8_BAR; G8_SCHED;
    G8_STAGE(G8_SB(0, 1), Bt, bcol + HALF, t + 2);
    G8_WV(6); G8_BAR; G8_MMA(1, 1, At, B1); G8_BAR;
    G8_LDB(B0, 1, 0); G8_SCHED; G8_LDA(At, 1, 0); G8_STAGE(G8_SA(0, 1), A, brow + HALF, t + 2);
    G8_WL(8); G8_BAR; G8_WL(0); G8_MMA(0, 0, At, B0); G8_BAR; G8_SCHED;
    G8_LDB(B1, 1, 1); G8_STAGE(G8_SB(1, 0), Bt, bcol, t + 3);
    G8_BAR; G8_WL(0); G8_MMA(0, 1, At, B1); G8_BAR;
    G8_LDA(At, 1, 1); G8_STAGE(G8_SA(1, 0), A, brow, t + 3);
    G8_BAR; G8_WL(0); G8_MMA(1, 0, At, B0); G8_BAR; G8_SCHED;
    G8_STAGE(G8_SB(1, 1), Bt, bcol + HALF, t + 3);
    G8_WV(6); G8_BAR; G8_MMA(1, 1, At, B1); G8_BAR;
  }
  { G8_LDB(B0, 0, 0); G8_LDA(At, 0, 0); G8_STAGE(G8_SA(1, 1), A, brow + HALF, nt - 1);
    G8_BAR; G8_WL(0); G8_MMA(0, 0, At, B0); G8_BAR;
    G8_LDB(B1, 0, 1); G8_BAR; G8_WL(0); G8_MMA(0, 1, At, B1); G8_BAR;
    G8_LDA(At, 0, 1); G8_WV(4); G8_BAR; G8_WL(0); G8_MMA(1, 0, At, B0); G8_MMA(1, 1, At, B1); G8_BAR; }
  { G8_LDB(B0, 1, 0); G8_LDA(At, 1, 0); G8_WV(2); G8_BAR; G8_WL(0); G8_MMA(0, 0, At, B0); G8_BAR;
    G8_LDB(B1, 1, 1); G8_WV(0); G8_BAR; G8_WL(0); G8_MMA(0, 1, At, B1); G8_BAR;
    G8_LDA(At, 1, 1); G8_BAR; G8_WL(0); G8_MMA(1, 0, At, B0); G8_MMA(1, 1, At, B1); G8_BAR; }
  if (wr == 0) G8_BAR;
#undef G8_SA
#undef G8_SB
#undef G8_STAGE
#undef G8_LDA
#undef G8_LDB
#undef G8_MMA
#undef G8_WV
#undef G8_WL
#undef G8_BAR
#undef G8_SCHED
}

DI void phase_inproj(const Params& p, int layer, char* lds) {
  const u16* xb = (const u16*)(p.ws + OFF_XB);
  const u16* wt = (const u16*)(p.ws + OFF_WIN) + (size_t)layer * DIN * DM;
  u16* H = (u16*)(p.ws + OFF_H);
  int tid_ = threadIdx.x; asm volatile("" : "+v"(tid_)); const int tid = tid_, lane = tid & 63, w = tid >> 6, l32 = lane & 31, hh = lane >> 5, wm = w & 1, wn = w >> 1;
  constexpr int NTN = 11, NRB = T / 256, NTILES = NRB * NTN;
  const float SC_DQ = 0.17677669529663687f * LOG2E, SC_SQ = 0.125f * LOG2E;
  const bool xcd_ok = (gridDim.x % 8) == 0;
  const int xj = xcd_ok ? (int)(blockIdx.x & 7) : 0, nbl = xcd_ok ? (int)(gridDim.x >> 3) : (int)gridDim.x;
  const int bl = xcd_ok ? (int)(blockIdx.x >> 3) : (int)blockIdx.x, per_x = xcd_ok ? NTILES / 8 : NTILES;
  for (int u = bl; u < per_x; u += nbl) {
    const int lr = u / NTN, nt = u % NTN;
    const int mt = xcd_ok ? lr * 8 + xj : lr, m0 = mt * 256, n0 = nt * 256;
    const int nvalid = (DIN - n0) < 256 ? (DIN - n0) : 256;
    (void)nvalid;
    f32x4 acc[2][2][4][2];
#pragma unroll
    for (int ai = 0; ai < 2; ++ai)
#pragma unroll
      for (int bj = 0; bj < 2; ++bj)
#pragma unroll
        for (int m = 0; m < 4; ++m)
#pragma unroll
          for (int n = 0; n < 2; ++n) acc[ai][bj][m][n] = (f32x4){0.f, 0.f, 0.f, 0.f};
    gemm8p(xb, wt, m0, n0, acc);
    const int wr8 = w >> 2, wc8 = w & 3, fr = lane & 15, fq = lane >> 4;
#pragma unroll
    for (int bj = 0; bj < 2; ++bj)
#pragma unroll
      for (int n = 0; n < 2; ++n) {
        const int cw = n0 + bj * 128 + wc8 * 32 + n * 16, col = cw + fr;
        u16* dst = H + cw; int dstr = DIN;
        {
          const int bb = m0 / S;
          if (cw >= C_DK && cw < C_DV) { const int o = cw - C_DK; dst = (u16*)(p.ws + OFF_DK) + ((size_t)(bb * 3 * S + (o >> 6) * S) << 6) + (o & 63); dstr = 64; }
          else if (cw >= C_DV && cw < C_SQ) { const int o = cw - C_DV; dst = (u16*)(p.ws + OFF_DV) + ((size_t)(bb * 3 * S + (o >> 6) * S) << 6) + (o & 63); dstr = 64; }
          else if (cw >= C_SK && cw < C_SV) { const int o = cw - C_SK; dst = (u16*)(p.ws + OFF_SK) + ((size_t)(bb * 1 * S + (o >> 6) * S) << 6) + (o & 63); dstr = 64; }
          else if (cw >= C_SV && cw < C_GATE) { const int o = cw - C_SV; dst = (u16*)(p.ws + OFF_SV) + ((size_t)(bb * 1 * S + (o >> 6) * S) << 6) + (o & 63); dstr = 64; }
        }
        if (cw < DIN) {
          float sc = 1.f;
          if (col >= C_DQ && col < C_DK) sc = SC_DQ;
          if (col >= C_SQ && col < C_SK) sc = SC_SQ;
          const bool gate = col >= C_GATE;
#pragma unroll
          for (int ai = 0; ai < 2; ++ai)
#pragma unroll
            for (int m = 0; m < 4; ++m) {
#pragma unroll
              for (int j = 0; j < 4; ++j) {
                const int row = m0 + ai * 128 + wr8 * 64 + m * 16 + fq * 4 + j;
                float v = acc[ai][bj][m][n][j] * sc;
                if (gate) v = v * __builtin_amdgcn_rcpf(1.f + __expf(-v));
                dst[(size_t)row * dstr + fr] = f2bf(v);
              }
              __builtin_amdgcn_sched_barrier(0);
            }
        }
      }
  }
}

DI void phase_mla_up(const Params& p, int layer, char* lds) {
  const u16* H = (const u16*)(p.ws + OFF_H);
  const u16* wuq = (const u16*)(p.ws + OFF_WUQ) + (size_t)layer * 576 * 192;
  const u16* wukv = (const u16*)(p.ws + OFF_WUKV) + (size_t)layer * 768 * 128;
  const f32x2* rt = (const f32x2*)(p.ws + OFF_ROPE);
  u16* QB = (u16*)(p.ws + OFF_QB); u16* KB = (u16*)(p.ws + OFF_KB); u16* VB = (u16*)(p.ws + OFF_VB);
  int tid_ = threadIdx.x; asm volatile("" : "+v"(tid_)); const int tid = tid_, lane = tid & 63, w = tid >> 6, l32 = lane & 31, hh = lane >> 5, wm = w & 3, wn = w >> 2;
  char* As = lds; char* Bs = lds + 128 * 400; float* rinv = (float*)(lds + 256 * 400);
  const float QSC = 0.10206207261596577f * LOG2E;
  for (int item = blockIdx.x; item < T / 128; item += gridDim.x) {
    const int m0 = item * 128;
#pragma unroll 1
    for (int part = 0; part < 2; ++part) {
      const int K = part == 0 ? 192 : 128, acol = part == 0 ? C_CQ : C_CKV, STR = (K + 8) * 2, CPR = K / 8;
      const int NCT = part == 0 ? 9 : 12;
      const u16* Wt = part == 0 ? wuq : wukv;
      __syncthreads();
      for (int c = tid; c < 128 * CPR; c += NTHR) { int row = c / CPR, ch = c % CPR;
        *(u32x4*)(As + row * STR + ch * 16) = *(const u32x4*)(H + (size_t)(m0 + row) * DIN + acol + ch * 8); }
      __syncthreads();
      {
        int row = tid >> 2, part4 = tid & 3, n = K / 4; float ss = 0.f;
        const u16* ar = (const u16*)(As + row * STR) + part4 * n;
        for (int i = 0; i < n; ++i) { float v = bf2f(ar[i]); ss += v * v; }
        ss += __shfl_xor(ss, 1); ss += __shfl_xor(ss, 2);
        if (part4 == 0) rinv[row] = rsqrtf(ss / (float)K + 1e-6f);
      }
      const int NCT2 = (NCT + 1) / 2, NOUT = NCT * 64;
      u32x4 rw[6];
      auto wload = [&](int ct) {
        int tl = tid; asm volatile("" : "+v"(tl));
#pragma unroll
        for (int i = 0; i < 6; ++i) { const int c = tl + NTHR * i; if (c < 128 * CPR) rw[i] = *(const u32x4*)(Wt + (size_t)ct * 128 * K + c * 8); }
      };
      auto epi = [&](const f32x16& acc, const int c0) {
        const int col = c0 + l32;
        if (part == 0) {
          const bool is_rope = (c0 % 96 == 64);
#pragma unroll
          for (int r = 0; r < 16; ++r) {
            const int lrow = 32 * wm + crow(r, hh), trow = m0 + lrow;
            float v = acc[r] * rinv[lrow] * QSC;
            if (is_rope) {
              float o = __shfl_xor(v, 16);
              f32x2 cs = rt[(size_t)(trow & (S - 1)) * 16 + (l32 & 15)];
              v = (l32 < 16) ? (v * cs[0] - o * cs[1]) : (v * cs[0] + o * cs[1]);
            }
            QB[(size_t)trow * QW + col] = f2bf(v);
          }
        } else {
          const int head = c0 >> 7, within = c0 & 127;
#pragma unroll
          for (int r = 0; r < 16; ++r) {
            const int lrow = 32 * wm + crow(r, hh), trow = m0 + lrow;
            float v = acc[r] * rinv[lrow];
            const size_t hrow = (size_t)((trow >> 13) * 6 + head) * S + (trow & (S - 1));
            if (within < 64) KB[hrow * 96 + within + l32] = f2bf(v);
            else VB[hrow * 64 + (within - 64) + l32] = f2bf(v);
          }
        }
      };
      wload(0);
#pragma unroll 1
      for (int ct = 0; ct < NCT2; ++ct) {
        {
          int tl = tid; asm volatile("" : "+v"(tl));
#pragma unroll
          for (int i = 0; i < 6; ++i) { const int c = tl + NTHR * i, row = c / CPR, ch = c % CPR; if (c < 128 * CPR) *(u32x4*)(Bs + row * STR + ch * 16) = rw[i]; }
        }
        LDS_BARRIER();
        if (ct + 1 < NCT2) wload(ct + 1);
        f32x16 acc0, acc1;
#pragma unroll
        for (int r = 0; r < 16; ++r) { acc0[r] = 0.f; acc1[r] = 0.f; }
        for (int st = 0; st < K / 16; ++st) {
          bf16x8 af = *(const bf16x8*)(As + (32 * wm + l32) * STR + (16 * st + 8 * hh) * 2);
          bf16x8 b0 = *(const bf16x8*)(Bs + (64 * wn + l32) * STR + (16 * st + 8 * hh) * 2);
          bf16x8 b1 = *(const bf16x8*)(Bs + (64 * wn + 32 + l32) * STR + (16 * st + 8 * hh) * 2);
          acc0 = MFMA(af, b0, acc0);
          acc1 = MFMA(af, b1, acc1);
        }
        const int c0 = ct * 128 + 64 * wn;
        if (c0 < NOUT) epi(acc0, c0);
        if (c0 + 32 < NOUT) epi(acc1, c0 + 32);
        LDS_BARRIER();
      }
    }
    for (int idx = tid; idx < 128 * 16; idx += NTHR) {
      const int row = idx >> 4, i = idx & 15, trow = m0 + row;
      float x1 = bf2f(H[(size_t)trow * DIN + C_KR + i]), x2 = bf2f(H[(size_t)trow * DIN + C_KR + 16 + i]);
      f32x2 cs = rt[(size_t)(trow & (S - 1)) * 16 + i];
      u16 o1 = f2bf(x1 * cs[0] - x2 * cs[1]), o2 = f2bf(x2 * cs[0] + x1 * cs[1]);
#pragma unroll
      for (int hd = 0; hd < 6; ++hd) { const size_t hrow = (size_t)((trow >> 13) * 6 + hd) * S + (trow & (S - 1)); KB[hrow * 96 + 64 + i] = o1; KB[hrow * 96 + 80 + i] = o2; }
    }
  }
}

constexpr int VSTR = 192;
template <int OFF>
DI void trread8(unsigned addr, s16x4 (&v)[8]) {
  asm volatile(
      "ds_read_b64_tr_b16 %0, %8 offset:%9\n\t"
      "ds_read_b64_tr_b16 %1, %8 offset:%10\n\t"
      "ds_read_b64_tr_b16 %2, %8 offset:%11\n\t"
      "ds_read_b64_tr_b16 %3, %8 offset:%12\n\t"
      "ds_read_b64_tr_b16 %4, %8 offset:%13\n\t"
      "ds_read_b64_tr_b16 %5, %8 offset:%14\n\t"
      "ds_read_b64_tr_b16 %6, %8 offset:%15\n\t"
      "ds_read_b64_tr_b16 %7, %8 offset:%16\n\t"
      "s_waitcnt lgkmcnt(0)"
      : "=&v"(v[0]), "=&v"(v[1]), "=&v"(v[2]), "=&v"(v[3]), "=&v"(v[4]), "=&v"(v[5]), "=&v"(v[6]), "=&v"(v[7])
      : "v"(addr), "i"(OFF + 0 * VSTR + 0), "i"(OFF + 8 * VSTR + 0), "i"(OFF + 0 * VSTR + 64), "i"(OFF + 8 * VSTR + 64),
        "i"(OFF + 16 * VSTR + 0), "i"(OFF + 24 * VSTR + 0), "i"(OFF + 16 * VSTR + 64), "i"(OFF + 24 * VSTR + 64)
      : "memory");
}

template <int MODE>
DI void attn_item(const Params& p, int layer, int bh, int qb, char* lds) {
  constexpr int KD = MODE == 0 ? 96 : 64, NMAP = MODE == 1 ? 2 : 1, QS = MODE == 0 ? 6 : (MODE == 1 ? 2 : 4);
  constexpr int KSTR = KD * 2 + 16, KBYTES = 64 * KSTR, VBYTES = 64 * VSTR, STAGE = KBYTES + VBYTES, KCH = (8 * KD + NTHR - 1) / NTHR, KCPR = KD / 8, KCHUNKS = 8 * KD;
  constexpr int BREL_BYTES = 2048;
  int tid_ = threadIdx.x; asm volatile("" : "+v"(tid_)); const int tid = tid_, lane = tid & 63, w = tid >> 6, l32 = lane & 31, hh = lane >> 5;
  const int q0 = qb * 256, q0w = q0 + 32 * w;
  const u16 *Qg, *Kg, *Vg; int qstr, kstr, vstr, ocol, b, hd;
  if (MODE == 0) {
    b = bh / 6; hd = bh % 6;
    Qg = (const u16*)(p.ws + OFF_QB) + (size_t)b * S * QW + hd * 96; qstr = QW;
    Kg = (const u16*)(p.ws + OFF_KB) + (size_t)(b * 6 + hd) * S * 96; kstr = 96;
    Vg = (const u16*)(p.ws + OFF_VB) + (size_t)(b * 6 + hd) * S * 64; vstr = 64;
    ocol = hd * 64;
  } else if (MODE == 1) {
    b = bh / 4; hd = bh % 4;
    const u16* Hb = (const u16*)(p.ws + OFF_H) + (size_t)b * S * DIN;
    Qg = Hb + C_DQ + hd * 64; qstr = DIN; kstr = vstr = 64;
    Kg = (const u16*)(p.ws + OFF_DK) + (size_t)(b * 4 + hd) * S * 64; Vg = (const u16*)(p.ws + OFF_DV) + (size_t)(b * 4 + hd) * S * 64;
    ocol = 384 + hd * 64;
  } else {
    b = bh / 6; hd = bh % 6;
    const u16* Hb = (const u16*)(p.ws + OFF_H) + (size_t)b * S * DIN;
    Qg = Hb + C_SQ + hd * 64; qstr = DIN; kstr = vstr = 64;
    Kg = (const u16*)(p.ws + OFF_SK) + (size_t)(b * 2 + hd / 3) * S * 64; Vg = (const u16*)(p.ws + OFF_SV) + (size_t)(b * 2 + hd / 3) * S * 64;
    ocol = 640 + hd * 64;
  }
  float* brel = (float*)lds;
  char* stage0 = lds + BREL_BYTES;
  if (MODE != 0) {
    const int bcol = MODE == 1 ? hd : 4 + hd;
    for (int i = tid; i < 512; i += NTHR) {
      int rel = i - 224, rc = rel < -128 ? -128 : (rel > 128 ? 128 : rel);
      float bv = p.relb[t5_bucket(rc) * 10 + bcol] * LOG2E;
      brel[i] = (MODE == 2 && rc != rel) ? -1e30f : bv;
    }
  }
  bf16x8 qf[NMAP][QS];
  {
    const u16* qrow = Qg + (size_t)(q0w + l32) * qstr + hh * 8;
#pragma unroll
    for (int mp = 0; mp < NMAP; ++mp)
#pragma unroll
      for (int st = 0; st < QS; ++st) qf[mp][st] = *(const bf16x8*)(qrow + (mp * QS + st) * 16);
  }
  f32x16 O[NMAP][2]; float m = 0.f, l[NMAP];
#pragma unroll
  for (int mp = 0; mp < NMAP; ++mp) {
#pragma unroll
    for (int r = 0; r < 16; ++r) { O[mp][0][r] = 0.f; O[mp][1][r] = 0.f; }
    l[mp] = 0.f;
  }
  if (MODE == 2) { m = p.sink[layer * 6 + hd] * LOG2E; l[0] = (hh == 0) ? 1.f : 0.f; }
  int kt0 = 0, kt1 = S / 64;
  if (MODE == 2) { kt0 = (q0 - 128) / 64; if (kt0 < 0) kt0 = 0; kt1 = (q0 + 384) / 64; if (kt1 > S / 64) kt1 = S / 64; }
  const int nt = kt1 - kt0;
  constexpr int KSTRG = MODE == 0 ? 96 : 64, VSTRG = 64;
  u32x4 rkA[KCH], rvA[1], rkB[KCH], rvB[1];
  auto gload = [&](int kt, u32x4 (&rk)[KCH], u32x4 (&rv)[1]) {
    const u16* kb = Kg + (size_t)kt * (64 * KSTRG);
    const u16* vb = Vg + (size_t)kt * (64 * VSTRG);
#pragma unroll
    for (int i = 0; i < KCH; ++i) if (tid + NTHR * i < KCHUNKS) rk[i] = *(const u32x4*)(kb + tid * 8 + NTHR * 8 * i);
    rv[0] = *(const u32x4*)(vb + tid * 8);
  };
  auto lstore = [&](int st, const u32x4 (&rk)[KCH], const u32x4 (&rv)[1]) {
    char* Ks = stage0 + st * STAGE;
#pragma unroll
    for (int i = 0; i < KCH; ++i) { int c = tid + NTHR * i, row = c / KCPR, ch = c % KCPR; if (c < KCHUNKS) *(u32x4*)(Ks + row * KSTR + ch * 16) = rk[i]; }
    { int row = tid >> 3, ch = tid & 7; *(u32x4*)(Ks + KBYTES + row * VSTR + ch * 16) = rv[0]; }
  };
  const unsigned vlane = (unsigned)((4 * hh + ((lane & 15) >> 2)) * VSTR + 32 * ((lane >> 4) & 1) + 8 * (lane & 3));
  bf16x8 kaug, qaug;
  { u32x4 tk = {hh == 0 ? 0x3F803F80u : 0u, 0u, 0u, 0u}; kaug = __builtin_bit_cast(bf16x8, tk); qaug = __builtin_bit_cast(bf16x8, (u32x4){0u, 0u, 0u, 0u}); }
  f32x16 c0p;
  auto set_c0 = [&](float c0) {
    const unsigned hi = f2bf(c0); const unsigned lo = f2bf(c0 - bf2f((u16)hi));
    u32x4 tq = {hh == 0 ? (hi | (lo << 16)) : 0u, 0u, 0u, 0u}; qaug = __builtin_bit_cast(bf16x8, tq);
    { const f32x16 z16 = {0.f, 0.f, 0.f, 0.f, 0.f, 0.f, 0.f, 0.f, 0.f, 0.f, 0.f, 0.f, 0.f, 0.f, 0.f, 0.f}; c0p = MFMA(kaug, qaug, z16); }
  };
  int c0cls = -1;
  auto compute = [&](const int t, const int cur) {
    const int k0 = (kt0 + t) * 64;
    const char* Ks = stage0 + cur * STAGE;
    bool active = true;
    if (MODE == 2) active = (k0 + 63 >= q0w - 128) && (k0 <= q0w + 159);
    if (active) {
      const float* brow = brel + (k0 - q0w - l32 + 4 * hh + 224);
      int cls = 0; float cb = 0.f;
      if (MODE == 1) {
        const int rmax = k0 + 63 - q0w, rmin = k0 - (q0w + 31);
        if (rmax <= -128) { cls = 1; cb = brel[224 - 128]; }
        else if (rmin >= 128) { cls = 2; cb = brel[224 + 128]; }
      }
      const bool far = cls != 0;
      if (cls != c0cls) { c0cls = cls; set_c0(cb - m); }
      const unsigned vaddr = (unsigned)(uintptr_t)(Ks + KBYTES) + vlane;
      typedef __attribute__((address_space(3))) s16x4 lds_s16x4;
      s16x4 vpre[16];
      u32x4 pk[NMAP][2][2];
#pragma unroll
      for (int mp = 0; mp < NMAP; ++mp) {
        f32x16 s[2];
        const f32x16 zero16 = {0.f, 0.f, 0.f, 0.f, 0.f, 0.f, 0.f, 0.f, 0.f, 0.f, 0.f, 0.f, 0.f, 0.f, 0.f, 0.f};
        __builtin_amdgcn_s_setprio(1);
        f32x16 c0tile;
        c0tile = c0p;
#pragma unroll
        for (int sub = 0; sub < 2; ++sub) {
#pragma unroll
          for (int st = 0; st < QS; ++st) {
            bf16x8 kf = *(const bf16x8*)(Ks + (32 * sub + l32) * KSTR + ((mp * QS + st) * 16 + hh * 8) * 2);
            if (st == 0) s[sub] = MFMA(kf, qf[mp][st], c0tile); else s[sub] = MFMA(kf, qf[mp][st], s[sub]);
          }
        }
        __builtin_amdgcn_iglp_opt(1);
        __builtin_amdgcn_s_setprio(0);
        if (NMAP == 1) {
          lds_s16x4* vb = (lds_s16x4*)(Ks + KBYTES + vlane);
#pragma unroll
          for (int i = 0; i < 16; ++i) {
            const int sub_ = i >> 3, ks_ = (i >> 2) & 1, dt_ = (i >> 1) & 1, g_ = i & 1;
            vpre[i] = __builtin_amdgcn_ds_read_tr16_b64_v4i16(vb + ((32 * sub_ + 16 * ks_ + 8 * g_) * VSTR + 64 * dt_) / 8);
          }
          __builtin_amdgcn_sched_barrier(0);
        }
        if (MODE != 0 && !far) {
#pragma unroll
          for (int sub = 0; sub < 2; ++sub)
#pragma unroll
            for (int r = 0; r < 16; ++r) s[sub][r] += brow[32 * sub + (r & 3) + 8 * (r >> 2)];
        }
        const bool first = (MODE != 2) && (t == 0) && (mp == 0);
        auto rebase = [&]() {
          float mx = fmaxf(fmaxf(s[0][0], s[0][1]), s[0][2]);
#pragma unroll
          for (int r = 3; r < 15; r += 2) mx = fmaxf(fmaxf(mx, s[0][r]), s[0][r + 1]);
          mx = fmaxf(mx, s[0][15]);
#pragma unroll
          for (int r = 0; r < 16; r += 2) mx = fmaxf(fmaxf(mx, s[1][r]), s[1][r + 1]);
          const float rm = xchg_max(mx);
          float delta = first ? rm : fmaxf(rm, 0.f);
          if (delta < -1e29f) delta = 0.f;
          m += delta;
          const float alpha = __builtin_amdgcn_exp2f(-delta);
#pragma unroll
          for (int mq = 0; mq < NMAP; ++mq) {
            l[mq] *= alpha;
#pragma unroll
            for (int r = 0; r < 16; ++r) { O[mq][0][r] *= alpha; O[mq][1][r] *= alpha; }
          }
#pragma unroll
          for (int r = 0; r < 16; ++r) { s[0][r] -= delta; s[1][r] -= delta; }
          set_c0(cb - m);
        };
        float ps;
        auto smpass = [&]() {
          ps = 0.f;
#pragma unroll
          for (int sub = 0; sub < 2; ++sub)
#pragma unroll
            for (int ks = 0; ks < 2; ++ks)
#pragma unroll
              for (int i = 0; i < 4; ++i) {
                const float p0 = __builtin_amdgcn_exp2f(s[sub][8 * ks + 2 * i]), p1 = __builtin_amdgcn_exp2f(s[sub][8 * ks + 2 * i + 1]);
                ps += p0 + p1; pk[mp][sub][ks][i] = pk2(p0, p1);
              }
        };
        if (first) rebase();
        smpass();
        if (!first && __any(!(ps <= PSLIM))) { rebase(); smpass(); }
        l[mp] += ps;
        __builtin_amdgcn_sched_barrier(0);
      }
#pragma unroll
      for (int sub = 0; sub < 2; ++sub) {
        s16x4 vv[8];
        if (NMAP == 1) {
#pragma unroll
          for (int i = 0; i < 8; ++i) vv[i] = vpre[sub * 8 + i];
        } else {
          if (sub == 0) trread8<0>(vaddr, vv); else trread8<32 * VSTR>(vaddr, vv);
        }
        __builtin_amdgcn_s_setprio(1);
#pragma unroll
        for (int ks = 0; ks < 2; ++ks) {
#pragma unroll
          for (int dt = 0; dt < 2; ++dt) {
            s16x4 lo = vv[ks * 4 + dt * 2], hi = vv[ks * 4 + dt * 2 + 1];
            bf16x8 vf = __builtin_shufflevector(lo, hi, 0, 1, 2, 3, 4, 5, 6, 7);
#pragma unroll
            for (int mp = 0; mp < NMAP; ++mp) O[mp][dt] = MFMA(vf, __builtin_bit_cast(bf16x8, pk[mp][sub][ks]), O[mp][dt]);
          }
        }
        __builtin_amdgcn_s_setprio(0);
        __builtin_amdgcn_sched_barrier(0);
      }
    }
  };
  __syncthreads();
  gload(kt0, rkA, rvA); lstore(0, rkA, rvA);
  if (nt > 1) gload(kt0 + 1, rkB, rvB);
  LDS_BARRIER();
  for (int t = 0; t < nt; t += 2) {
    if (t + 2 < nt) gload(kt0 + t + 2, rkA, rvA);
    compute(t, 0);
    if (t + 1 < nt) lstore(1, rkB, rvB);
    LDS_BARRIER();
    if (t + 1 >= nt) break;
    if (t + 3 < nt) gload(kt0 + t + 3, rkB, rvB);
    compute(t + 1, 1);
    if (t + 2 < nt) lstore(0, rkA, rvA);
    LDS_BARRIER();
  }
  __syncthreads();
  const size_t trow = (size_t)b * S + q0w + l32;
  const u16* grow = (const u16*)(p.ws + OFF_H) + trow * DIN + C_GATE + ocol;
  u16* orow = (u16*)(p.ws + OFF_OB) + trow * DM + ocol;
  float inv0 = 1.f / xchg_sum(l[0]);
  if (MODE == 1) {
    const float* lm = (const float*)(p.ws + OFF_LAM);
    const float lam = lm[layer], post = lm[4 + layer];
    const float inv1 = lam / xchg_sum(l[1]);
    float ss = 0.f;
#pragma unroll
    for (int dt = 0; dt < 2; ++dt)
#pragma unroll
      for (int r = 0; r < 16; ++r) { float v = O[0][dt][r] * inv0 - O[NMAP - 1][dt][r] * inv1; O[0][dt][r] = v; ss += v * v; }
    ss = xchg_sum(ss);
    inv0 = rsqrtf(ss * (1.f / 64.f) + 1e-6f) * post;
  }
#pragma unroll
  for (int dt = 0; dt < 2; ++dt)
#pragma unroll
    for (int g = 0; g < 4; ++g) {
      const int d = 32 * dt + 8 * g + 4 * hh;
      u32x2 gw = *(const u32x2*)(grow + d);
      float v0 = O[0][dt][4 * g + 0] * inv0, v1 = O[0][dt][4 * g + 1] * inv0, v2 = O[0][dt][4 * g + 2] * inv0, v3 = O[0][dt][4 * g + 3] * inv0;
      if (MODE == 1) { const float* sl = p.subln + layer * 64 + d; v0 *= sl[0]; v1 *= sl[1]; v2 *= sl[2]; v3 *= sl[3]; }
      v0 *= bflo(gw[0]); v1 *= bfhi(gw[0]); v2 *= bflo(gw[1]); v3 *= bfhi(gw[1]);
      u32x2 ow = {pk2(v0, v1), pk2(v2, v3)};
#ifdef PROBE_ZERO_MODE
      if (MODE == PROBE_ZERO_MODE) { ow[0] = 0u; ow[1] = 0u; }
#endif
      *(u32x2*)(orow + d) = ow;
    }
}

DI void phase_attn(const Params& p, int layer, char* lds) {
  constexpr int N_MLA = 24 * 32, N_DIFF = 16 * 32, N_SWA = 24 * 32;
  for (int g = blockIdx.x; g < N_MLA + N_DIFF + N_SWA; g += gridDim.x) {
    if (g < N_MLA) { int i = g; attn_item<0>(p, layer, (i & 7) + 8 * (i >> 8), (i >> 3) & 31, lds); }
    else if (g < N_MLA + N_DIFF) { int i = g - N_MLA; attn_item<1>(p, layer, (i & 7) + 8 * (i >> 8), (i >> 3) & 31, lds); }
    else { int i = g - N_MLA - N_DIFF; attn_item<2>(p, layer, (i & 7) + 8 * (i >> 8), (i >> 3) & 31, lds); }
  }
}

DI void phase_outproj(const Params& p, int layer, char* lds) {
  const u16* ob = (const u16*)(p.ws + OFF_OB);
  const u16* wt = (const u16*)(p.ws + OFF_WOUT) + (size_t)layer * DM * DM;
  const float* xres = layer == 0 ? p.x : p.out;
  float* xout = p.out;
  int tid_ = threadIdx.x; asm volatile("" : "+v"(tid_)); const int tid = tid_, lane = tid & 63, w = tid >> 6, l32 = lane & 31, hh = lane >> 5, wm = w & 1, wn = w >> 1;
  constexpr int NTN = DM / 256, NRB = T / 256, NTILES = NRB * NTN;
  const bool xcd_ok = (gridDim.x % 8) == 0;
  const int xj = xcd_ok ? (int)(blockIdx.x & 7) : 0, nbl = xcd_ok ? (int)(gridDim.x >> 3) : (int)gridDim.x;
  const int bl = xcd_ok ? (int)(blockIdx.x >> 3) : (int)blockIdx.x, per_x = xcd_ok ? NTILES / 8 : NTILES;
  for (int u = bl; u < per_x; u += nbl) {
    const int lr = u / NTN, nt = u % NTN, mt = xcd_ok ? lr * 8 + xj : lr, m0 = mt * 256, n0 = nt * 256;
    const int wr8 = w >> 2, wc8 = w & 3, fr = lane & 15, fq = lane >> 4;
    const size_t base = (size_t)(m0 + wr8 * 64 + fq * 4) * DM + (n0 + wc8 * 32 + fr);
    f32x4 acc[2][2][4][2];
#pragma unroll
    for (int ai = 0; ai < 2; ++ai)
#pragma unroll
      for (int bj = 0; bj < 2; ++bj)
#pragma unroll
        for (int m = 0; m < 4; ++m)
#pragma unroll
          for (int n = 0; n < 2; ++n) acc[ai][bj][m][n] = (f32x4){0.f, 0.f, 0.f, 0.f};
    gemm8p(ob, wt, m0, n0, acc);
    u16* yo = (u16*)(p.ws + OFF_XB) + base;
#pragma unroll
    for (int ai = 0; ai < 2; ++ai)
#pragma unroll
      for (int bj = 0; bj < 2; ++bj)
#pragma unroll
        for (int m = 0; m < 4; ++m) {
#pragma unroll
          for (int n = 0; n < 2; ++n)
#pragma unroll
            for (int j = 0; j < 4; ++j) yo[(ai * 128 + m * 16 + j) * DM + bj * 128 + n * 16] = f2bf(acc[ai][bj][m][n][j]);
          __builtin_amdgcn_sched_barrier(0);
        }
  }
}

DI void phase_ln(const Params& p, int layer) {
  const float* xres = layer == 0 ? p.x : p.out;
  float* xout = p.out;
  u16* xb = (u16*)(p.ws + OFF_XB);
  const float* lg = p.ln_g + layer * DM; const float* lb = p.ln_b + layer * DM;
  int tid_ = threadIdx.x; asm volatile("" : "+v"(tid_)); const int tid = tid_, lane = tid & 63, w = tid >> 6;
#pragma unroll 1
  for (size_t row = (size_t)blockIdx.x * 8 + w; row < (size_t)T; row += (size_t)gridDim.x * 8) {
    f32x4 v[4]; float sum = 0.f;
#pragma unroll
    for (int i = 0; i < 4; ++i) {
      const f32x4 xv = *(const f32x4*)(xres + row * DM + 4 * lane + 256 * i);
      const u32x2 yw = *(const u32x2*)(xb + row * DM + 4 * lane + 256 * i);
      v[i][0] = ALPHA * xv[0] + bflo(yw[0]); v[i][1] = ALPHA * xv[1] + bfhi(yw[0]); v[i][2] = ALPHA * xv[2] + bflo(yw[1]); v[i][3] = ALPHA * xv[3] + bfhi(yw[1]);
      sum += v[i][0] + v[i][1] + v[i][2] + v[i][3];
    }
    const float mu = wave_sum(sum) * (1.f / DM);
    float sq = 0.f;
#pragma unroll
    for (int i = 0; i < 4; ++i)
#pragma unroll
      for (int j = 0; j < 4; ++j) { float d = v[i][j] - mu; sq += d * d; }
    const float rstd = rsqrtf(wave_sum(sq) * (1.f / DM) + 1e-5f);
#pragma unroll
    for (int i = 0; i < 4; ++i) {
      const int col = 4 * lane + 256 * i;
      f32x4 g = *(const f32x4*)(lg + col), bb = *(const f32x4*)(lb + col), o;
#pragma unroll
      for (int j = 0; j < 4; ++j) o[j] = (v[i][j] - mu) * rstd * g[j] + bb[j];
      *(f32x4*)(xout + row * DM + col) = o;
      if (layer + 1 < DEPTH) {
        u32x2 ow = {pk2(o[0], o[1]), pk2(o[2], o[3])};
        *(u32x2*)(xb + row * DM + col) = ow;
      }
    }
  }
}

#if MK_COOP
DI void fast_grid_sync(unsigned* ctr, unsigned& epoch) {
  asm volatile("s_waitcnt vmcnt(0) lgkmcnt(0)" ::: "memory");
  __syncthreads();
  epoch += 1u;
  if (threadIdx.x == 0) {
    __builtin_amdgcn_fence(__ATOMIC_RELEASE, "agent");
    asm volatile("s_waitcnt vmcnt(0)" ::: "memory");
    const unsigned target = epoch * gridDim.x;
    (void)__hip_atomic_fetch_add(ctr, 1u, __ATOMIC_RELAXED, __HIP_MEMORY_SCOPE_AGENT);
    unsigned spins = 0;
    while (__hip_atomic_load(ctr, __ATOMIC_RELAXED, __HIP_MEMORY_SCOPE_AGENT) < target) {
      __builtin_amdgcn_s_sleep(2);
      if (++spins > (1u << 26)) break;
    }
    __builtin_amdgcn_fence(__ATOMIC_ACQUIRE, "agent");
    asm volatile("s_waitcnt vmcnt(0)" ::: "memory");
  }
  __syncthreads();
}

__global__ void __launch_bounds__(NTHR) fwd_megakernel(Params p) {
  char* lds = lds_dyn;
  cg::grid_group grid = cg::this_grid();
  unsigned* bar_ctr = (unsigned*)(p.ws + OFF_BAR); unsigned bar_epoch = 0;
  phase_prep(p, lds);
  grid.sync();
  for (int layer = 0; layer < DEPTH; ++layer) {
    phase_inproj(p, layer, lds);
    fast_grid_sync(bar_ctr, bar_epoch);
    phase_mla_up(p, layer, lds);
    fast_grid_sync(bar_ctr, bar_epoch);
#ifdef PROBE_REP_P12
    phase_inproj(p, layer, lds);
    fast_grid_sync(bar_ctr, bar_epoch);
    phase_mla_up(p, layer, lds);
    fast_grid_sync(bar_ctr, bar_epoch);
#endif
#ifdef PROBE_REP_P2
    phase_mla_up(p, layer, lds);
    fast_grid_sync(bar_ctr, bar_epoch);
#endif
    phase_attn(p, layer, lds);
#ifdef PROBE_REP_ATTN
    fast_grid_sync(bar_ctr, bar_epoch);
    phase_attn(p, layer, lds);
#endif
    fast_grid_sync(bar_ctr, bar_epoch);
    phase_outproj(p, layer, lds);
    fast_grid_sync(bar_ctr, bar_epoch);
    phase_ln(p, layer);
    if (layer + 1 < DEPTH) fast_grid_sync(bar_ctr, bar_epoch);
  }
}
#else
template <int PH>
__global__ void __launch_bounds__(NTHR, 2) phase_kernel(Params p, int layer) {
  __shared__ __attribute__((aligned(16))) char lds[LDS_BYTES];
  if (PH == 0) phase_prep(p, lds);
  if (PH == 1) phase_inproj(p, layer, lds);
  if (PH == 2) phase_mla_up(p, layer, lds);
  if (PH == 3) phase_attn(p, layer, lds);
  if (PH == 4) phase_outproj(p, layer, lds);
  if (PH == 5) phase_ln(p, layer);
}
#endif

extern "C" void kernel_launch(void* const* d_in, const int* in_sizes, int n_in, void* d_out, int out_size, void* d_ws, size_t ws_size,
                              hipStream_t stream) {
  if (n_in != 13 || ws_size < WS_END || out_size != T * DM) {
    fprintf(stderr, "kernel_launch: unexpected shapes n_in %d ws %zu (need %zu) out %d\n", n_in, ws_size, WS_END, out_size);
    return;
  }
  Params p{};
  p.x = (const float*)d_in[0]; p.w_in = (const float*)d_in[1]; p.qn = (const float*)d_in[2]; p.kvn = (const float*)d_in[3];
  p.w_uq = (const float*)d_in[4]; p.w_ukv = (const float*)d_in[5]; p.lamv = (const float*)d_in[6]; p.subln = (const float*)d_in[7];
  p.sink = (const float*)d_in[8]; p.relb = (const float*)d_in[9]; p.w_out = (const float*)d_in[10]; p.ln_g = (const float*)d_in[11];
  p.ln_b = (const float*)d_in[12]; p.out = (float*)d_out; p.ws = (char*)d_ws;
#if MK_COOP
  static int grid_blocks = 0;
  if (!grid_blocks) {
    int dev = 0, cus = 0, per_cu = 0;
    hipGetDevice(&dev);
    hipDeviceGetAttribute(&cus, hipDeviceAttributeMultiprocessorCount, dev);
    if (hipFuncSetAttribute((const void*)fwd_megakernel, hipFuncAttributeMaxDynamicSharedMemorySize, LDS_BYTES) != hipSuccess)
      fprintf(stderr, "kernel_launch: hipFuncSetAttribute(%d B dynamic LDS) failed\n", LDS_BYTES);
    hipOccupancyMaxActiveBlocksPerMultiprocessor(&per_cu, fwd_megakernel, NTHR, LDS_BYTES);
    (void)hipGetLastError();
    (void)per_cu;
    grid_blocks = cus;
  }
  (void)hipMemsetAsync((char*)d_ws + OFF_BAR, 0, 256, stream);
  void* args[] = {&p};
  hipError_t e = hipLaunchCooperativeKernel((void*)fwd_megakernel, dim3(grid_blocks), dim3(NTHR), args, LDS_BYTES, stream);
  if (e != hipSuccess) fprintf(stderr, "cooperative launch failed: %s (grid %d)\n", hipGetErrorString(e), grid_blocks);
#else
  const int G = 512;
  hipLaunchKernelGGL(phase_kernel<0>, dim3(G), dim3(NTHR), 0, stream, p, 0);
  for (int l = 0; l < DEPTH; ++l) {
    hipLaunchKernelGGL(phase_kernel<1>, dim3(G), dim3(NTHR), 0, stream, p, l);
    hipLaunchKernelGGL(phase_kernel<2>, dim3(G), dim3(NTHR), 0, stream, p, l);
    hipLaunchKernelGGL(phase_kernel<3>, dim3(G), dim3(NTHR), 0, stream, p, l);
    hipLaunchKernelGGL(phase_kernel<4>, dim3(G), dim3(NTHR), 0, stream, p, l);
    hipLaunchKernelGGL(phase_kernel<5>, dim3(G), dim3(NTHR), 0, stream, p, l);
  }
#endif
}
```

```cpp
#include <hip/hip_runtime.h>
#include <hip/hip_cooperative_groups.h>
#include <cstdio>
#include <cstdint>
namespace cg = cooperative_groups;

#ifndef MK_COOP
#define MK_COOP 1
#endif

#define DI __device__ __forceinline__
typedef unsigned short u16;
using bf16x8 = __attribute__((ext_vector_type(8))) short;
using s16x4  = __attribute__((ext_vector_type(4))) short;
using f32x16 = __attribute__((ext_vector_type(16))) float;
using f32x4  = __attribute__((ext_vector_type(4))) float;
using f32x2  = __attribute__((ext_vector_type(2))) float;
using u32x4  = __attribute__((ext_vector_type(4))) unsigned;
using u32x2  = __attribute__((ext_vector_type(2))) unsigned;
using b16x2  = __attribute__((ext_vector_type(2))) __bf16;
#define MFMA(a, b, c) __builtin_amdgcn_mfma_f32_32x32x16_bf16((a), (b), (c), 0, 0, 0)

constexpr int NB = 4, S = 8192, T = NB * S, DM = 1024, DIN = 2784, DEPTH = 4;
constexpr int C_CQ = 0, C_CKV = 192, C_KR = 320, C_DQ = 352, C_DK = 608, C_DV = 864, C_SQ = 1120, C_SK = 1504, C_SV = 1632, C_GATE = 1760;
constexpr int QW = 576, KW = 576, VW = 384;
constexpr float LOG2E = 1.4426950408889634f;
constexpr float ALPHA = 1.681792830507429f;
constexpr int NTHR = 512;
constexpr float PSLIM = 4096.0f;

constexpr size_t SZ_WIN = (size_t)DEPTH * DIN * DM * 2, SZ_WOUT = (size_t)DEPTH * DM * DM * 2;
constexpr size_t SZ_WUQ = (size_t)DEPTH * 576 * 192 * 2, SZ_WUKV = (size_t)DEPTH * 768 * 128 * 2;
constexpr size_t SZ_ROPE = (size_t)S * 16 * 8, SZ_LAM = 256;
constexpr size_t SZ_XB = (size_t)T * DM * 2, SZ_H = (size_t)T * DIN * 2, SZ_QB = (size_t)T * QW * 2, SZ_KB = (size_t)T * KW * 2;
constexpr size_t SZ_VB = (size_t)T * VW * 2, SZ_OB = (size_t)T * DM * 2, SZ_DK = (size_t)T * 256 * 2, SZ_SK = (size_t)T * 128 * 2;
constexpr size_t OFF_WIN = 0, OFF_WOUT = OFF_WIN + SZ_WIN, OFF_WUQ = OFF_WOUT + SZ_WOUT, OFF_WUKV = OFF_WUQ + SZ_WUQ;
constexpr size_t OFF_ROPE = OFF_WUKV + SZ_WUKV, OFF_LAM = OFF_ROPE + SZ_ROPE, OFF_XB = OFF_LAM + SZ_LAM, OFF_H = OFF_XB + SZ_XB;
constexpr size_t OFF_QB = OFF_H + SZ_H, OFF_KB = OFF_QB + SZ_QB, OFF_VB = OFF_KB + SZ_KB, OFF_OB = OFF_VB + SZ_VB, OFF_DK = OFF_OB + SZ_OB, OFF_DV = OFF_DK + SZ_DK, OFF_SK = OFF_DV + SZ_DK, OFF_SV = OFF_SK + SZ_SK, OFF_BAR = OFF_SV + SZ_SK, WS_END = OFF_BAR + 256;

struct Params {
  const float *x, *w_in, *qn, *kvn, *w_uq, *w_ukv, *lamv, *subln, *sink, *relb, *w_out, *ln_g, *ln_b;
  float* out;
  char* ws;
};

extern __shared__ __attribute__((aligned(16))) char lds_dyn[];
constexpr int LDS_BYTES = 147456;

DI u16 f2bf(float x) { unsigned u = __float_as_uint(x); u += 0x7fffu + ((u >> 16) & 1u); return (u16)(u >> 16); }
DI float bf2f(u16 b) { return __uint_as_float(((unsigned)b) << 16); }
DI unsigned pk2(float lo, float hi) { f32x2 v = {lo, hi}; b16x2 r = __builtin_convertvector(v, b16x2); return __builtin_bit_cast(unsigned, r); }
DI float bflo(unsigned w) { return __uint_as_float(w << 16); }
DI float bfhi(unsigned w) { return __uint_as_float(w & 0xffff0000u); }
DI int crow(int r, int hh) { return (r & 3) + 8 * (r >> 2) + 4 * hh; }
DI float xchg_max(float v) {
  auto rr = __builtin_amdgcn_permlane32_swap(__float_as_uint(v), __float_as_uint(v), false, false);
  return fmaxf(__uint_as_float(rr[0]), __uint_as_float(rr[1]));
}
DI float xchg_sum(float v) {
  auto rr = __builtin_amdgcn_permlane32_swap(__float_as_uint(v), __float_as_uint(v), false, false);
  return __uint_as_float(rr[0]) + __uint_as_float(rr[1]);
}
DI float wave_sum(float v) {
  for (int o = 32; o >= 1; o >>= 1) v += __shfl_xor(v, o);
  return v;
}
DI int t5_bucket(int rel) {
  int n = rel < 0 ? -rel : rel;
  int b;
  if (n < 8) b = n;
  else b = 8 + (n >= 12) + (n >= 16) + (n >= 23) + (n >= 32) + (n >= 46) + (n >= 64) + (n >= 91);
  return b + (rel > 0 ? 16 : 0);
}
DI bf16x8 pack8(const f32x16& x, int s8) {
  u32x4 p = {pk2(x[s8 + 0], x[s8 + 1]), pk2(x[s8 + 2], x[s8 + 3]), pk2(x[s8 + 4], x[s8 + 5]), pk2(x[s8 + 6], x[s8 + 7])};
  return __builtin_bit_cast(bf16x8, p);
}

__device__ __constant__ float ROPE_FREQ[16] = {
  1.0f, 0.5623413324356079f, 0.3162277638912201f, 0.17782793939113617f, 0.10000000149011612f, 0.05623413249850273f,
  0.03162277489900589f, 0.017782794311642647f, 0.009999999776482582f, 0.005623413249850273f, 0.003162277629598975f,
  0.0017782794311642647f, 0.0010000000474974513f, 0.000562341301701963f, 0.0003162277571391314f, 0.00017782794020604342f};

DI void prep_transpose_tile(const float* __restrict__ src, u16* __restrict__ dst, int R, int C, const float* __restrict__ g, int tr, int tc, float* lds) {
  int tid_ = threadIdx.x; asm volatile("" : "+v"(tid_)); const int tid = tid_;
  for (int i = tid; i < 4096; i += NTHR) {
    int r = i >> 6, c = i & 63, gr = tr * 64 + r, gc = tc * 64 + c;
    float v = 0.f;
    if (gr < R && gc < C) { v = src[(size_t)gr * C + gc]; if (g) v *= g[gr]; }
    lds[r * 65 + c] = v;
  }
  __syncthreads();
  for (int i = tid; i < 4096; i += NTHR) {
    int c = i >> 6, r = i & 63, gr = tr * 64 + r, gc = tc * 64 + c;
    if (gr < R && gc < C) dst[(size_t)gc * R + gr] = f2bf(lds[r * 65 + c]);
  }
  __syncthreads();
}

DI void sincos_d(double a, float& c, float& s) {
  const double TWO_PI = 6.283185307179586476925286766559, INV_TWO_PI = 0.15915494309189533576888376337251;
  double n = rint(a * INV_TWO_PI);
  double r = fma(-n, TWO_PI, a);
  r = fma(-n, 2.4492935982947064e-16, r);
  double r2 = r * r;
  double sp = 1.0 / 15511210043330985984000000.0;
  sp = fma(sp, r2, -1.0 / 25852016738884976640000.0);
  sp = fma(sp, r2, 1.0 / 51090942171709440000.0);
  sp = fma(sp, r2, -1.0 / 121645100408832000.0);
  sp = fma(sp, r2, 1.0 / 355687428096000.0);
  sp = fma(sp, r2, -1.0 / 1307674368000.0);
  sp = fma(sp, r2, 1.0 / 6227020800.0);
  sp = fma(sp, r2, -1.0 / 39916800.0);
  sp = fma(sp, r2, 1.0 / 362880.0);
  sp = fma(sp, r2, -1.0 / 5040.0);
  sp = fma(sp, r2, 1.0 / 120.0);
  sp = fma(sp, r2, -1.0 / 6.0);
  sp = fma(sp, r2, 1.0);
  double cp = 1.0 / 620448401733239439360000.0;
  cp = fma(cp, r2, -1.0 / 1124000727777607680000.0);
  cp = fma(cp, r2, 1.0 / 2432902008176640000.0);
  cp = fma(cp, r2, -1.0 / 6402373705728000.0);
  cp = fma(cp, r2, 1.0 / 20922789888000.0);
  cp = fma(cp, r2, -1.0 / 87178291200.0);
  cp = fma(cp, r2, 1.0 / 479001600.0);
  cp = fma(cp, r2, -1.0 / 3628800.0);
  cp = fma(cp, r2, 1.0 / 40320.0);
  cp = fma(cp, r2, -1.0 / 720.0);
  cp = fma(cp, r2, 1.0 / 24.0);
  cp = fma(cp, r2, -0.5);
  cp = fma(cp, r2, 1.0);
  s = (float)(sp * r); c = (float)cp;
}

DI void phase_prep(const Params& p, char* lds) {
  u16* wt_in = (u16*)(p.ws + OFF_WIN); u16* wt_out = (u16*)(p.ws + OFF_WOUT);
  u16* wt_uq = (u16*)(p.ws + OFF_WUQ); u16* wt_ukv = (u16*)(p.ws + OFF_WUKV);
  constexpr int N_IN = 16 * 44, N_OUT = 16 * 16, N_UQ = 3 * 9, N_UKV = 2 * 12;
  constexpr int PER_L = N_IN + N_OUT + N_UQ + N_UKV;
  for (int it = blockIdx.x; it < DEPTH * PER_L; it += gridDim.x) {
    int l = it / PER_L, j = it % PER_L;
    if (j < N_IN) prep_transpose_tile(p.w_in + (size_t)l * DM * DIN, wt_in + (size_t)l * DIN * DM, DM, DIN, nullptr, j / 44, j % 44, (float*)lds);
    else if ((j -= N_IN) < N_OUT) prep_transpose_tile(p.w_out + (size_t)l * DM * DM, wt_out + (size_t)l * DM * DM, DM, DM, nullptr, j / 16, j % 16, (float*)lds);
    else if ((j -= N_OUT) < N_UQ) prep_transpose_tile(p.w_uq + (size_t)l * 192 * 576, wt_uq + (size_t)l * 576 * 192, 192, 576, p.qn + l * 192, j / 9, j % 9, (float*)lds);
    else { j -= N_UQ; prep_transpose_tile(p.w_ukv + (size_t)l * 128 * 768, wt_ukv + (size_t)l * 768 * 128, 128, 768, p.kvn + l * 128, j / 12, j % 12, (float*)lds); }
  }
  const size_t gtid = (size_t)blockIdx.x * NTHR + threadIdx.x, gsz = (size_t)gridDim.x * NTHR;
  u16* xb = (u16*)(p.ws + OFF_XB);
  for (size_t i = gtid; i < (size_t)T * DM / 8; i += gsz) {
    f32x4 a = *(const f32x4*)(p.x + i * 8), b = *(const f32x4*)(p.x + i * 8 + 4);
    u32x4 o = {pk2(a[0], a[1]), pk2(a[2], a[3]), pk2(b[0], b[1]), pk2(b[2], b[3])};
    *(u32x4*)(xb + i * 8) = o;
  }
  f32x2* rt = (f32x2*)(p.ws + OFF_ROPE);
  for (size_t i = gtid; i < (size_t)S * 16; i += gsz) {
    int pos = (int)(i >> 4), k = (int)(i & 15);
    float ang = (float)pos * ROPE_FREQ[k];
    float c, s; sincos_d((double)ang, c, s);
    f32x2 v = {c, s}; rt[i] = v;
  }
  if (blockIdx.x == 0 && threadIdx.x < DEPTH) {
    int l = threadIdx.x; const float* lv = p.lamv + l * 128;
    float d1 = 0.f, d2 = 0.f;
    for (int i = 0; i < 32; ++i) { d1 += lv[i] * lv[32 + i]; d2 += lv[64 + i] * lv[96 + i]; }
    float lam_init = 0.8f - 0.6f * expf(-0.3f * (float)l);
    float* lm = (float*)(p.ws + OFF_LAM);
    lm[l] = expf(d1) - expf(d2) + lam_init;
    lm[4 + l] = 1.0f - lam_init;
  }
}

#define LDS_BARRIER() asm volatile("s_waitcnt lgkmcnt(0)\n\ts_barrier" ::: "memory")
DI void gemm256(const u16* __restrict__ A, int lda, const u16* __restrict__ Bt, int ldb, int m0, int n0, int nvalid, int K,
                char* lds, f32x16 (&acc)[4][2], const float* cinit = nullptr) {
  constexpr int ASZ = 256 * 144, STG = 2 * ASZ;
  int tid_ = threadIdx.x; asm volatile("" : "+v"(tid_)); const int tid = tid_, lane = tid & 63, w = tid >> 6, l32 = lane & 31, hh = lane >> 5, wm = w & 1, wn = w >> 1;
  if (cinit) {
    const float* cp = cinit + (size_t)(m0 + 128 * wm + 4 * hh) * DM + (n0 + 64 * wn + l32);
#pragma unroll
    for (int mi = 0; mi < 4; ++mi)
#pragma unroll
      for (int ni = 0; ni < 2; ++ni)
#pragma unroll
        for (int r = 0; r < 16; ++r) acc[mi][ni][r] = ALPHA * cp[(32 * mi + (r & 3) + 8 * (r >> 2)) * DM + 32 * ni];
  } else {
#pragma unroll
    for (int mi = 0; mi < 4; ++mi)
#pragma unroll
      for (int ni = 0; ni < 2; ++ni)
#pragma unroll
        for (int r = 0; r < 16; ++r) acc[mi][ni][r] = 0.f;
  }
  u32x4 ra[4], rb[4];
  const int KT = K / 64;
  const int lrow = tid >> 3, lch = tid & 7;
  const u16* ap = A + (size_t)(m0 + lrow) * lda + lch * 8;
  const u16* bp = Bt + (size_t)(n0 + lrow) * ldb + lch * 8;
  auto gload = [&](int kt) {
#pragma unroll
    for (int i = 0; i < 4; ++i) ra[i] = *(const u32x4*)(ap + (size_t)(64 * i) * lda + kt * 64);
#pragma unroll
    for (int i = 0; i < 4; ++i) { u32x4 z = {0u, 0u, 0u, 0u};
      rb[i] = (lrow + 64 * i < nvalid) ? *(const u32x4*)(bp + (size_t)(64 * i) * ldb + kt * 64) : z; }
  };
  auto lstore = [&](int st) {
    char* As = lds + st * STG + lrow * 144 + lch * 16;
#pragma unroll
    for (int i = 0; i < 4; ++i) *(u32x4*)(As + 64 * i * 144) = ra[i];
#pragma unroll
    for (int i = 0; i < 4; ++i) *(u32x4*)(As + ASZ + 64 * i * 144) = rb[i];
  };
  auto compute = [&](int st) {
    const char* As = lds + st * STG + (128 * wm + l32) * 144 + hh * 16;
    const char* Bs = lds + st * STG + ASZ + (64 * wn + l32) * 144 + hh * 16;
    bf16x8 a0[4], b0[2], a1[4], b1[2];
#define LDFRAG(K16, AF, BF) do { _Pragma("unroll") for (int mi = 0; mi < 4; ++mi) AF[mi] = *(const bf16x8*)(As + 32 * mi * 144 + (K16) * 32); \
    _Pragma("unroll") for (int ni = 0; ni < 2; ++ni) BF[ni] = *(const bf16x8*)(Bs + 32 * ni * 144 + (K16) * 32); } while (0)
#define MMSTEP(AF, BF) do { _Pragma("unroll") for (int mi = 0; mi < 4; ++mi) _Pragma("unroll") for (int ni = 0; ni < 2; ++ni) acc[mi][ni] = MFMA(AF[mi], BF[ni], acc[mi][ni]); } while (0)
#define SGB(mask, n) __builtin_amdgcn_sched_group_barrier(mask, n, 0)
#define PIPE_STEP() do { SGB(0x100, 1); SGB(0x008, 1); SGB(0x100, 1); SGB(0x008, 1); SGB(0x100, 1); SGB(0x008, 1); SGB(0x100, 1); SGB(0x008, 1); \
    SGB(0x100, 1); SGB(0x008, 1); SGB(0x100, 1); SGB(0x008, 1); SGB(0x008, 2); } while (0)
    LDFRAG(0, a0, b0);
    LDFRAG(1, a1, b1); MMSTEP(a0, b0);
    LDFRAG(2, a0, b0); MMSTEP(a1, b1);
    LDFRAG(3, a1, b1); MMSTEP(a0, b0);
    MMSTEP(a1, b1);
    __builtin_amdgcn_iglp_opt(1);
#undef LDFRAG
#undef MMSTEP
#undef PIPE_STEP
  };
  gload(0); lstore(0);
  LDS_BARRIER();
  for (int kt = 0; kt < KT; ++kt) {
    if (kt + 1 < KT) gload(kt + 1);
    compute(kt & 1);
    if (kt + 1 < KT) lstore((kt + 1) & 1);
    LDS_BARRIER();
  }
}

DI int g8_lds_byte(int r, int c) { int st = (r >> 4) * 2 + (c >> 5), rr = r & 15, cc = c & 31, ob = rr * 64 + cc * 2; return st * 1024 + (ob ^ (((ob >> 9) & 1) << 5)); }
DI void g8_stage_rc(int b, int& R, int& C) { int st = b / 1024, sb = b % 1024, swz = sb ^ (((sb >> 9) & 1) << 5); R = (st >> 1) * 16 + swz / 64; C = (st & 1) * 32 + (swz % 64) / 2; }
DI void gemm8p(const u16* __restrict__ A, const u16* __restrict__ Bt, int brow, int bcol, f32x4 (&acc)[2][2][4][2]) {
  constexpr int K = 1024, BK = 64, HALF = 128, HT = HALF * BK;
  u16* shm = (u16*)lds_dyn;
#define G8_SA(b, h) (shm + ((b) * 2 + (h)) * HT)
#define G8_SB(b, h) (shm + (4 + (b) * 2 + (h)) * HT)
#define G8_STAGE(P, BASE, br, kt) do { const u16* gb_ = (BASE) + ((long)(br) * K + (long)(kt) * BK);     \
      __builtin_amdgcn_global_load_lds((const unsigned*)(gb_ + soff0), (__attribute__((address_space(3))) unsigned*)((char*)(P) + tid8 * 16), 16, 0, 0); \
      __builtin_amdgcn_global_load_lds((const unsigned*)(gb_ + soff1), (__attribute__((address_space(3))) unsigned*)((char*)(P) + tid8 * 16 + 8192), 16, 0, 0); } while (0)
#define G8_LDA(dst, b, h) for (int m = 0; m < 4; ++m) for (int k = 0; k < 2; ++k) \
    dst[m][k] = *reinterpret_cast<const bf16x8*>((char*)G8_SA(b, h) + g8_lds_byte(wr * 64 + m * 16 + fr, k * 32 + fq * 8))
#define G8_LDB(dst, b, h) for (int n = 0; n < 2; ++n) for (int k = 0; k < 2; ++k) \
    dst[n][k] = *reinterpret_cast<const bf16x8*>((char*)G8_SB(b, h) + g8_lds_byte(wc * 32 + n * 16 + fr, k * 32 + fq * 8))
#define G8_MMA(ai, bj, At_, Bt_) do { __builtin_amdgcn_s_setprio(1); \
    for (int m = 0; m < 4; ++m) for (int n = 0; n < 2; ++n) for (int k = 0; k < 2; ++k) \
      acc[ai][bj][m][n] = __builtin_amdgcn_mfma_f32_16x16x32_bf16(At_[m][k], Bt_[n][k], acc[ai][bj][m][n], 0, 0, 0); \
    __builtin_amdgcn_s_setprio(0); } while (0)
#define G8_WV(n) asm volatile("s_waitcnt vmcnt(" #n ")" ::: "memory")
#define G8_WL(n) asm volatile("s_waitcnt lgkmcnt(" #n ")" ::: "memory")
#define G8_BAR __builtin_amdgcn_s_barrier()
#define G8_SCHED __builtin_amdgcn_sched_barrier(0)
  int tid8 = threadIdx.x; asm volatile("" : "+v"(tid8));
  const int wid = tid8 >> 6, lane = tid8 & 63, wr = wid >> 2, wc = wid & 3, fr = lane & 15, fq = lane >> 4;
  int soff0, soff1;
  { int r_, c_; g8_stage_rc(tid8 * 16, r_, c_); soff0 = r_ * K + c_; g8_stage_rc(tid8 * 16 + 8192, r_, c_); soff1 = r_ * K + c_; }
  bf16x8 At[4][2], B0[2][2], B1[2][2];
  constexpr int nt = K / BK;
  __syncthreads();
  G8_STAGE(G8_SB(0, 0), Bt, bcol, 0); G8_STAGE(G8_SA(0, 0), A, brow, 0);
  G8_STAGE(G8_SB(0, 1), Bt, bcol + HALF, 0); G8_STAGE(G8_SA(0, 1), A, brow + HALF, 0);
  if (wr == 1) G8_BAR;
  G8_WV(4); G8_BAR;
  G8_STAGE(G8_SB(1, 0), Bt, bcol, 1); G8_STAGE(G8_SA(1, 0), A, brow, 1); G8_STAGE(G8_SB(1, 1), Bt, bcol + HALF, 1);
  G8_WV(6); G8_BAR;
#pragma unroll 1
  for (int t = 0; t < nt - 2; t += 2) {
    G8_LDB(B0, 0, 0); G8_SCHED; G8_LDA(At, 0, 0); G8_STAGE(G8_SA(1, 1), A, brow + HALF, t + 1);
    G8_WL(8); G8_BAR; G8_WL(0); G8_MMA(0, 0, At, B0); G8_BAR; G8_SCHED;
    G8_LDB(B1, 0, 1); G8_STAGE(G8_SB(0, 0), Bt, bcol, t + 2);
    G8_BAR; G8_WL(0); G8_MMA(0, 1, At, B1); G8_BAR;
    G8_LDA(At, 0, 1); G8_STAGE(G8_SA(0, 0), A, brow, t + 2);
    G8_BAR; G8_WL(0); G8_MMA(1, 0, At, B0); G8_BAR; G8_SCHED;
    G8_STAGE(G8_SB(0, 1), Bt, bcol + HALF, t + 2);
    G8_WV(6); G8_BAR; G8_MMA(1, 1, At, B1); G8_BAR;
    G8_LDB(B0, 1, 0); G8_SCHED; G8_LDA(At, 1, 0); G8_STAGE(G8_SA(0, 1), A, brow + HALF, t + 2);
    G8_WL(8); G8_BAR; G8_WL(0); G8_MMA(0, 0, At, B0); G8_BAR; G8_SCHED;
    G8_LDB(B1, 1, 1); G8_STAGE(G8_SB(1, 0), Bt, bcol, t + 3);
    G8_BAR; G8_WL(0); G8_MMA(0, 1, At, B1); G8_BAR;
    G8_LDA(At, 1, 1); G8_STAGE(G8_SA(1, 0), A, brow, t + 3);
    G8_BAR; G8_WL(0); G8_MMA(1, 0, At, B0); G8_BAR; G8_SCHED;
    G8_STAGE(G8_SB(1, 1), Bt, bcol + HALF, t + 3);
    G8_WV(6); G8_BAR; G8_MMA(1, 1, At, B1); G8_BAR;
  }
  { G8_LDB(B0, 0, 0); G8_LDA(At, 0, 0); G8_STAGE(G8_SA(1, 1), A, brow + HALF, nt - 1);
    G8_BAR; G8_WL(0); G8_MMA(0, 0, At, B0); G8_BAR;
    G8_LDB(B1, 0, 1); G8_BAR; G8_WL(0); G8_MMA(0, 1, At, B1); G8_BAR;
    G8_LDA(At, 0, 1); G8_WV(4); G8_BAR; G8_WL(0); G8_MMA(1, 0, At, B0); G8_MMA(1, 1, At, B1); G8_BAR; }
  { G8_LDB(B0, 1, 0); G8_LDA(At, 1, 0); G8_WV(2); G8_BAR; G8_WL(0); G8_MMA(0, 0, At, B0); G8_BAR;
    G8_LDB(B1, 1, 1); G8_WV(0); G8_BAR; G8_WL(0); G8_MMA(0, 1, At, B1); G8_BAR;
    G8_LDA(At, 1, 1); G8_BAR; G8_WL(0); G8_MMA(1, 0, At, B0); G8_MMA(1, 1, At, B1); G8_BAR; }
  if (wr == 0) G8_BAR;
#undef G8_SA
#undef G8_SB
#undef G8_STAGE
#undef G8_LDA
#undef G8_LDB
#undef G8_MMA
#undef G8_WV
#undef G8_WL
#undef G8_BAR
#undef G8_SCHED
}

DI void phase_inproj(const Params& p, int layer, char* lds) {
  const u16* xb = (const u16*)(p.ws + OFF_XB);
  const u16* wt = (const u16*)(p.ws + OFF_WIN) + (size_t)layer * DIN * DM;
  u16* H = (u16*)(p.ws + OFF_H);
  int tid_ = threadIdx.x; asm volatile("" : "+v"(tid_)); const int tid = tid_, lane = tid & 63, w = tid >> 6, l32 = lane & 31, hh = lane >> 5, wm = w & 1, wn = w >> 1;
  constexpr int NTN = 11, NRB = T / 256, NTILES = NRB * NTN;
  const float SC_DQ = 0.17677669529663687f * LOG2E, SC_SQ = 0.125f * LOG2E;
  const bool xcd_ok = (gridDim.x % 8) == 0;
  const int xj = xcd_ok ? (int)(blockIdx.x & 7) : 0, nbl = xcd_ok ? (int)(gridDim.x >> 3) : (int)gridDim.x;
  const int bl = xcd_ok ? (int)(blockIdx.x >> 3) : (int)blockIdx.x, per_x = xcd_ok ? NTILES / 8 : NTILES;
  for (int u = bl; u < per_x; u += nbl) {
    const int lr = u / NTN, nt = u % NTN;
    const int mt = xcd_ok ? lr * 8 + xj : lr, m0 = mt * 256, n0 = nt * 256;
    const int nvalid = (DIN - n0) < 256 ? (DIN - n0) : 256;
    (void)nvalid;
    f32x4 acc[2][2][4][2];
#pragma unroll
    for (int ai = 0; ai < 2; ++ai)
#pragma unroll
      for (int bj = 0; bj < 2; ++bj)
#pragma unroll
        for (int m = 0; m < 4; ++m)
#pragma unroll
          for (int n = 0; n < 2; ++n) acc[ai][bj][m][n] = (f32x4){0.f, 0.f, 0.f, 0.f};
    gemm8p(xb, wt, m0, n0, acc);
    const int wr8 = w >> 2, wc8 = w & 3, fr = lane & 15, fq = lane >> 4;
#pragma unroll
    for (int bj = 0; bj < 2; ++bj)
#pragma unroll
      for (int n = 0; n < 2; ++n) {
        const int cw = n0 + bj * 128 + wc8 * 32 + n * 16, col = cw + fr;
        u16* dst = H + cw; int dstr = DIN;
        {
          const int bb = m0 / S;
          if (cw >= C_DK && cw < C_DV) { const int o = cw - C_DK; dst = (u16*)(p.ws + OFF_DK) + ((size_t)(bb * 3 * S + (o >> 6) * S) << 6) + (o & 63); dstr = 64; }
          else if (cw >= C_DV && cw < C_SQ) { const int o = cw - C_DV; dst = (u16*)(p.ws + OFF_DV) + ((size_t)(bb * 3 * S + (o >> 6) * S) << 6) + (o & 63); dstr = 64; }
          else if (cw >= C_SK && cw < C_SV) { const int o = cw - C_SK; dst = (u16*)(p.ws + OFF_SK) + ((size_t)(bb * 1 * S + (o >> 6) * S) << 6) + (o & 63); dstr = 64; }
          else if (cw >= C_SV && cw < C_GATE) { const int o = cw - C_SV; dst = (u16*)(p.ws + OFF_SV) + ((size_t)(bb * 1 * S + (o >> 6) * S) << 6) + (o & 63); dstr = 64; }
        }
        if (cw < DIN) {
          float sc = 1.f;
          if (col >= C_DQ && col < C_DK) sc = SC_DQ;
          if (col >= C_SQ && col < C_SK) sc = SC_SQ;
          const bool gate = col >= C_GATE;
#pragma unroll
          for (int ai = 0; ai < 2; ++ai)
#pragma unroll
            for (int m = 0; m < 4; ++m) {
#pragma unroll
              for (int j = 0; j < 4; ++j) {
                const int row = m0 + ai * 128 + wr8 * 64 + m * 16 + fq * 4 + j;
                float v = acc[ai][bj][m][n][j] * sc;
                if (gate) v = v * __builtin_amdgcn_rcpf(1.f + __expf(-v));
                dst[(size_t)row * dstr + fr] = f2bf(v);
              }
              __builtin_amdgcn_sched_barrier(0);
            }
        }
      }
  }
}

DI void phase_mla_up(const Params& p, int layer, char* lds) {
  const u16* H = (const u16*)(p.ws + OFF_H);
  const u16* wuq = (const u16*)(p.ws + OFF_WUQ) + (size_t)layer * 576 * 192;
  const u16* wukv = (const u16*)(p.ws + OFF_WUKV) + (size_t)layer * 768 * 128;
  const f32x2* rt = (const f32x2*)(p.ws + OFF_ROPE);
  u16* QB = (u16*)(p.ws + OFF_QB); u16* KB = (u16*)(p.ws + OFF_KB); u16* VB = (u16*)(p.ws + OFF_VB);
  int tid_ = threadIdx.x; asm volatile("" : "+v"(tid_)); const int tid = tid_, lane = tid & 63, w = tid >> 6, l32 = lane & 31, hh = lane >> 5, wm = w & 3, wn = w >> 2;
  char* As = lds; char* Bs = lds + 128 * 400; float* rinv = (float*)(lds + 256 * 400);
  const float QSC = 0.10206207261596577f * LOG2E;
  for (int item = blockIdx.x; item < T / 128; item += gridDim.x) {
    const int m0 = item * 128;
#pragma unroll 1
    for (int part = 0; part < 2; ++part) {
      const int K = part == 0 ? 192 : 128, acol = part == 0 ? C_CQ : C_CKV, STR = (K + 8) * 2, CPR = K / 8;
      const int NCT = part == 0 ? 9 : 12;
      const u16* Wt = part == 0 ? wuq : wukv;
      __syncthreads();
      for (int c = tid; c < 128 * CPR; c += NTHR) { int row = c / CPR, ch = c % CPR;
        *(u32x4*)(As + row * STR + ch * 16) = *(const u32x4*)(H + (size_t)(m0 + row) * DIN + acol + ch * 8); }
      __syncthreads();
      {
        int row = tid >> 2, part4 = tid & 3, n = K / 4; float ss = 0.f;
        const u16* ar = (const u16*)(As + row * STR) + part4 * n;
        for (int i = 0; i < n; ++i) { float v = bf2f(ar[i]); ss += v * v; }
        ss += __shfl_xor(ss, 1); ss += __shfl_xor(ss, 2);
        if (part4 == 0) rinv[row] = rsqrtf(ss / (float)K + 1e-6f);
      }
      const int NCT2 = (NCT + 1) / 2, NOUT = NCT * 64;
      u32x4 rw[6];
      auto wload = [&](int ct) {
        int tl = tid; asm volatile("" : "+v"(tl));
#pragma unroll
        for (int i = 0; i < 6; ++i) { const int c = tl + NTHR * i; if (c < 128 * CPR) rw[i] = *(const u32x4*)(Wt + (size_t)ct * 128 * K + c * 8); }
      };
      __syncthreads();
      float rv[16];
#pragma unroll
      for (int r = 0; r < 16; ++r) rv[r] = rinv[32 * wm + crow(r, hh)] * (part == 0 ? QSC : 1.f);
      const int rowb = m0 + 32 * wm + 4 * hh;
      const int bq = m0 >> 13, srow = rowb & (S - 1);
      auto epi = [&](const f32x16& acc, const int c0) {
        if (part == 0) {
          const bool is_rope = (c0 % 96 == 64);
          u16* qp = QB + (size_t)rowb * QW + c0 + l32;
          const f32x2* rp = rt + (size_t)srow * 16 + (l32 & 15);
#pragma unroll
          for (int r = 0; r < 16; ++r) {
            const int ro = (r & 3) + 8 * (r >> 2);
            float v = acc[r] * rv[r];
            if (is_rope) {
              float o = __shfl_xor(v, 16);
              f32x2 cs = rp[ro * 16];
              v = (l32 < 16) ? (v * cs[0] - o * cs[1]) : (v * cs[0] + o * cs[1]);
            }
            qp[ro * QW] = (u16)(pk2(v, 0.f) & 0xffffu);
          }
        } else {
          const int head = c0 >> 7, within = c0 & 127;
          const size_t hrow = (size_t)(bq * 6 + head) * S + srow;
          if (within < 64) {
            u16* kp = KB + hrow * 96 + within + l32;
#pragma unroll
            for (int r = 0; r < 16; ++r) kp[((r & 3) + 8 * (r >> 2)) * 96] = (u16)(pk2(acc[r] * rv[r], 0.f) & 0xffffu);
          } else {
            u16* vp = VB + hrow * 64 + (within - 64) + l32;
#pragma unroll
            for (int r = 0; r < 16; ++r) vp[((r & 3) + 8 * (r >> 2)) * 64] = (u16)(pk2(acc[r] * rv[r], 0.f) & 0xffffu);
          }
        }
      };
      wload(0);
#pragma unroll 1
      for (int ct = 0; ct < NCT2; ++ct) {
        {
          int tl = tid; asm volatile("" : "+v"(tl));
#pragma unroll
          for (int i = 0; i < 6; ++i) { const int c = tl + NTHR * i, row = c / CPR, ch = c % CPR; if (c < 128 * CPR) *(u32x4*)(Bs + row * STR + ch * 16) = rw[i]; }
        }
        LDS_BARRIER();
        if (ct + 1 < NCT2) wload(ct + 1);
        f32x16 acc0, acc1;
#pragma unroll
        for (int r = 0; r < 16; ++r) { acc0[r] = 0.f; acc1[r] = 0.f; }
        for (int st = 0; st < K / 16; ++st) {
          bf16x8 af = *(const bf16x8*)(As + (32 * wm + l32) * STR + (16 * st + 8 * hh) * 2);
          bf16x8 b0 = *(const bf16x8*)(Bs + (64 * wn + l32) * STR + (16 * st + 8 * hh) * 2);
          bf16x8 b1 = *(const bf16x8*)(Bs + (64 * wn + 32 + l32) * STR + (16 * st + 8 * hh) * 2);
          acc0 = MFMA(af, b0, acc0);
          acc1 = MFMA(af, b1, acc1);
        }
        const int c0 = ct * 128 + 64 * wn;
        if (c0 < NOUT) epi(acc0, c0);
        if (c0 + 32 < NOUT) epi(acc1, c0 + 32);
        LDS_BARRIER();
      }
    }
    for (int idx = tid; idx < 128 * 16; idx += NTHR) {
      const int row = idx >> 4, i = idx & 15, trow = m0 + row;
      float x1 = bf2f(H[(size_t)trow * DIN + C_KR + i]), x2 = bf2f(H[(size_t)trow * DIN + C_KR + 16 + i]);
      f32x2 cs = rt[(size_t)(trow & (S - 1)) * 16 + i];
      u16 o1 = f2bf(x1 * cs[0] - x2 * cs[1]), o2 = f2bf(x2 * cs[0] + x1 * cs[1]);
#pragma unroll
      for (int hd = 0; hd < 6; ++hd) { const size_t hrow = (size_t)((trow >> 13) * 6 + hd) * S + (trow & (S - 1)); KB[hrow * 96 + 64 + i] = o1; KB[hrow * 96 + 80 + i] = o2; }
    }
  }
}

constexpr int VSTR = 192;
template <int OFF>
DI void trread8(unsigned addr, s16x4 (&v)[8]) {
  asm volatile(
      "ds_read_b64_tr_b16 %0, %8 offset:%9\n\t"
      "ds_read_b64_tr_b16 %1, %8 offset:%10\n\t"
      "ds_read_b64_tr_b16 %2, %8 offset:%11\n\t"
      "ds_read_b64_tr_b16 %3, %8 offset:%12\n\t"
      "ds_read_b64_tr_b16 %4, %8 offset:%13\n\t"
      "ds_read_b64_tr_b16 %5, %8 offset:%14\n\t"
      "ds_read_b64_tr_b16 %6, %8 offset:%15\n\t"
      "ds_read_b64_tr_b16 %7, %8 offset:%16\n\t"
      "s_waitcnt lgkmcnt(0)"
      : "=&v"(v[0]), "=&v"(v[1]), "=&v"(v[2]), "=&v"(v[3]), "=&v"(v[4]), "=&v"(v[5]), "=&v"(v[6]), "=&v"(v[7])
      : "v"(addr), "i"(OFF + 0 * VSTR + 0), "i"(OFF + 8 * VSTR + 0), "i"(OFF + 0 * VSTR + 64), "i"(OFF + 8 * VSTR + 64),
        "i"(OFF + 16 * VSTR + 0), "i"(OFF + 24 * VSTR + 0), "i"(OFF + 16 * VSTR + 64), "i"(OFF + 24 * VSTR + 64)
      : "memory");
}

template <int MODE>
DI void attn_item(const Params& p, int layer, int bh, int qb, char* lds) {
  constexpr int KD = MODE == 0 ? 96 : 64, NMAP = MODE == 1 ? 2 : 1, QS = MODE == 0 ? 6 : (MODE == 1 ? 2 : 4);
  constexpr int KSTR = KD * 2 + 16, KBYTES = 64 * KSTR, VBYTES = 64 * VSTR, STAGE = KBYTES + VBYTES, KCH = (8 * KD + NTHR - 1) / NTHR, KCPR = KD / 8, KCHUNKS = 8 * KD;
  constexpr int BREL_BYTES = 2048;
  int tid_ = threadIdx.x; asm volatile("" : "+v"(tid_)); const int tid = tid_, lane = tid & 63, w = tid >> 6, l32 = lane & 31, hh = lane >> 5;
  const int q0 = qb * 256, q0w = q0 + 32 * w;
  const u16 *Qg, *Kg, *Vg; int qstr, kstr, vstr, ocol, b, hd;
  if (MODE == 0) {
    b = bh / 6; hd = bh % 6;
    Qg = (const u16*)(p.ws + OFF_QB) + (size_t)b * S * QW + hd * 96; qstr = QW;
    Kg = (const u16*)(p.ws + OFF_KB) + (size_t)(b * 6 + hd) * S * 96; kstr = 96;
    Vg = (const u16*)(p.ws + OFF_VB) + (size_t)(b * 6 + hd) * S * 64; vstr = 64;
    ocol = hd * 64;
  } else if (MODE == 1) {
    b = bh / 4; hd = bh % 4;
    const u16* Hb = (const u16*)(p.ws + OFF_H) + (size_t)b * S * DIN;
    Qg = Hb + C_DQ + hd * 64; qstr = DIN; kstr = vstr = 64;
    Kg = (const u16*)(p.ws + OFF_DK) + (size_t)(b * 4 + hd) * S * 64; Vg = (const u16*)(p.ws + OFF_DV) + (size_t)(b * 4 + hd) * S * 64;
    ocol = 384 + hd * 64;
  } else {
    b = bh / 6; hd = bh % 6;
    const u16* Hb = (const u16*)(p.ws + OFF_H) + (size_t)b * S * DIN;
    Qg = Hb + C_SQ + hd * 64; qstr = DIN; kstr = vstr = 64;
    Kg = (const u16*)(p.ws + OFF_SK) + (size_t)(b * 2 + hd / 3) * S * 64; Vg = (const u16*)(p.ws + OFF_SV) + (size_t)(b * 2 + hd / 3) * S * 64;
    ocol = 640 + hd * 64;
  }
  float* brel = (float*)lds;
  char* stage0 = lds + BREL_BYTES;
  if (MODE != 0) {
    const int bcol = MODE == 1 ? hd : 4 + hd;
    for (int i = tid; i < 512; i += NTHR) {
      int rel = i - 224, rc = rel < -128 ? -128 : (rel > 128 ? 128 : rel);
      float bv = p.relb[t5_bucket(rc) * 10 + bcol] * LOG2E;
      brel[i] = (MODE == 2 && rc != rel) ? -1e30f : bv;
    }
  }
  bf16x8 qf[NMAP][QS];
  {
    const u16* qrow = Qg + (size_t)(q0w + l32) * qstr + hh * 8;
#pragma unroll
    for (int mp = 0; mp < NMAP; ++mp)
#pragma unroll
      for (int st = 0; st < QS; ++st) qf[mp][st] = *(const bf16x8*)(qrow + (mp * QS + st) * 16);
  }
  f32x16 O[NMAP][2]; float m = 0.f, l[NMAP];
#pragma unroll
  for (int mp = 0; mp < NMAP; ++mp) {
#pragma unroll
    for (int r = 0; r < 16; ++r) { O[mp][0][r] = 0.f; O[mp][1][r] = 0.f; }
    l[mp] = 0.f;
  }
  if (MODE == 2) { m = p.sink[layer * 6 + hd] * LOG2E; l[0] = (hh == 0) ? 1.f : 0.f; }
  int kt0 = 0, kt1 = S / 64;
  if (MODE == 2) { kt0 = (q0 - 128) / 64; if (kt0 < 0) kt0 = 0; kt1 = (q0 + 384) / 64; if (kt1 > S / 64) kt1 = S / 64; }
  const int nt = kt1 - kt0;
  constexpr int KSTRG = MODE == 0 ? 96 : 64, VSTRG = 64;
  u32x4 rkA[KCH], rvA[1], rkB[KCH], rvB[1];
  auto gload = [&](int kt, u32x4 (&rk)[KCH], u32x4 (&rv)[1]) {
    const u16* kb = Kg + (size_t)kt * (64 * KSTRG);
    const u16* vb = Vg + (size_t)kt * (64 * VSTRG);
#pragma unroll
    for (int i = 0; i < KCH; ++i) if (tid + NTHR * i < KCHUNKS) rk[i] = *(const u32x4*)(kb + tid * 8 + NTHR * 8 * i);
    rv[0] = *(const u32x4*)(vb + tid * 8);
  };
  auto lstore = [&](int st, const u32x4 (&rk)[KCH], const u32x4 (&rv)[1]) {
    char* Ks = stage0 + st * STAGE;
#pragma unroll
    for (int i = 0; i < KCH; ++i) { int c = tid + NTHR * i, row = c / KCPR, ch = c % KCPR; if (c < KCHUNKS) *(u32x4*)(Ks + row * KSTR + ch * 16) = rk[i]; }
    { int row = tid >> 3, ch = tid & 7; *(u32x4*)(Ks + KBYTES + row * VSTR + ch * 16) = rv[0]; }
  };
  const unsigned vlane = (unsigned)((4 * hh + ((lane & 15) >> 2)) * VSTR + 32 * ((lane >> 4) & 1) + 8 * (lane & 3));
  bf16x8 kaug, qaug;
  { u32x4 tk = {hh == 0 ? 0x3F803F80u : 0u, 0u, 0u, 0u}; kaug = __builtin_bit_cast(bf16x8, tk); qaug = __builtin_bit_cast(bf16x8, (u32x4){0u, 0u, 0u, 0u}); }
  f32x16 c0p;
  auto set_c0 = [&](float c0) {
    const unsigned hi = f2bf(c0); const unsigned lo = f2bf(c0 - bf2f((u16)hi));
    u32x4 tq = {hh == 0 ? (hi | (lo << 16)) : 0u, 0u, 0u, 0u}; qaug = __builtin_bit_cast(bf16x8, tq);
    { const f32x16 z16 = {0.f, 0.f, 0.f, 0.f, 0.f, 0.f, 0.f, 0.f, 0.f, 0.f, 0.f, 0.f, 0.f, 0.f, 0.f, 0.f}; c0p = MFMA(kaug, qaug, z16); }
  };
  int c0cls = -1;
  auto compute = [&](const int t, const int cur) {
    const int k0 = (kt0 + t) * 64;
    const char* Ks = stage0 + cur * STAGE;
    bool active = true;
    if (MODE == 2) active = (k0 + 63 >= q0w - 128) && (k0 <= q0w + 159);
    if (active) {
      const float* brow = brel + (k0 - q0w - l32 + 4 * hh + 224);
      int cls = 0; float cb = 0.f;
      if (MODE == 1) {
        const int rmax = k0 + 63 - q0w, rmin = k0 - (q0w + 31);
        if (rmax <= -128) { cls = 1; cb = brel[224 - 128]; }
        else if (rmin >= 128) { cls = 2; cb = brel[224 + 128]; }
      }
      const bool far = cls != 0;
      if (cls != c0cls) { c0cls = cls; set_c0(cb - m); }
      const unsigned vaddr = (unsigned)(uintptr_t)(Ks + KBYTES) + vlane;
      typedef __attribute__((address_space(3))) s16x4 lds_s16x4;
      s16x4 vpre[16];
      u32x4 pk[NMAP][2][2];
#pragma unroll
      for (int mp = 0; mp < NMAP; ++mp) {
        f32x16 s[2];
        const f32x16 zero16 = {0.f, 0.f, 0.f, 0.f, 0.f, 0.f, 0.f, 0.f, 0.f, 0.f, 0.f, 0.f, 0.f, 0.f, 0.f, 0.f};
        __builtin_amdgcn_s_setprio(1);
        f32x16 c0tile;
        c0tile = c0p;
#pragma unroll
        for (int sub = 0; sub < 2; ++sub) {
#pragma unroll
          for (int st = 0; st < QS; ++st) {
            bf16x8 kf = *(const bf16x8*)(Ks + (32 * sub + l32) * KSTR + ((mp * QS + st) * 16 + hh * 8) * 2);
            if (st == 0) s[sub] = MFMA(kf, qf[mp][st], c0tile); else s[sub] = MFMA(kf, qf[mp][st], s[sub]);
          }
        }
        __builtin_amdgcn_iglp_opt(1);
        __builtin_amdgcn_s_setprio(0);
        if (NMAP == 1) {
          lds_s16x4* vb = (lds_s16x4*)(Ks + KBYTES + vlane);
#pragma unroll
          for (int i = 0; i < 16; ++i) {
            const int sub_ = i >> 3, ks_ = (i >> 2) & 1, dt_ = (i >> 1) & 1, g_ = i & 1;
            vpre[i] = __builtin_amdgcn_ds_read_tr16_b64_v4i16(vb + ((32 * sub_ + 16 * ks_ + 8 * g_) * VSTR + 64 * dt_) / 8);
          }
          __builtin_amdgcn_sched_barrier(0);
        }
        if (MODE != 0 && !far) {
#pragma unroll
          for (int sub = 0; sub < 2; ++sub)
#pragma unroll
            for (int r = 0; r < 16; ++r) s[sub][r] += brow[32 * sub + (r & 3) + 8 * (r >> 2)];
        }
        const bool first = (MODE != 2) && (t == 0) && (mp == 0);
        auto rebase = [&]() {
          float mx = fmaxf(fmaxf(s[0][0], s[0][1]), s[0][2]);
#pragma unroll
          for (int r = 3; r < 15; r += 2) mx = fmaxf(fmaxf(mx, s[0][r]), s[0][r + 1]);
          mx = fmaxf(mx, s[0][15]);
#pragma unroll
          for (int r = 0; r < 16; r += 2) mx = fmaxf(fmaxf(mx, s[1][r]), s[1][r + 1]);
          const float rm = xchg_max(mx);
          float delta = first ? rm : fmaxf(rm, 0.f);
          if (delta < -1e29f) delta = 0.f;
          m += delta;
          const float alpha = __builtin_amdgcn_exp2f(-delta);
#pragma unroll
          for (int mq = 0; mq < NMAP; ++mq) {
            l[mq] *= alpha;
#pragma unroll
            for (int r = 0; r < 16; ++r) { O[mq][0][r] *= alpha; O[mq][1][r] *= alpha; }
          }
#pragma unroll
          for (int r = 0; r < 16; ++r) { s[0][r] -= delta; s[1][r] -= delta; }
          set_c0(cb - m);
        };
        float ps;
        auto smpass = [&]() {
          ps = 0.f;
#pragma unroll
          for (int sub = 0; sub < 2; ++sub)
#pragma unroll
            for (int ks = 0; ks < 2; ++ks)
#pragma unroll
              for (int i = 0; i < 4; ++i) {
                const float p0 = __builtin_amdgcn_exp2f(s[sub][8 * ks + 2 * i]), p1 = __builtin_amdgcn_exp2f(s[sub][8 * ks + 2 * i + 1]);
                ps += p0 + p1; pk[mp][sub][ks][i] = pk2(p0, p1);
              }
        };
        if (first) rebase();
        smpass();
        if (!first && __any(!(ps <= PSLIM))) { rebase(); smpass(); }
        l[mp] += ps;
        __builtin_amdgcn_sched_barrier(0);
      }
#pragma unroll
      for (int sub = 0; sub < 2; ++sub) {
        s16x4 vv[8];
        if (NMAP == 1) {
#pragma unroll
          for (int i = 0; i < 8; ++i) vv[i] = vpre[sub * 8 + i];
        } else {
          if (sub == 0) trread8<0>(vaddr, vv); else trread8<32 * VSTR>(vaddr, vv);
        }
        __builtin_amdgcn_s_setprio(1);
#pragma unroll
        for (int ks = 0; ks < 2; ++ks) {
#pragma unroll
          for (int dt = 0; dt < 2; ++dt) {
            s16x4 lo = vv[ks * 4 + dt * 2], hi = vv[ks * 4 + dt * 2 + 1];
            bf16x8 vf = __builtin_shufflevector(lo, hi, 0, 1, 2, 3, 4, 5, 6, 7);
#pragma unroll
            for (int mp = 0; mp < NMAP; ++mp) O[mp][dt] = MFMA(vf, __builtin_bit_cast(bf16x8, pk[mp][sub][ks]), O[mp][dt]);
          }
        }
        __builtin_amdgcn_s_setprio(0);
        __builtin_amdgcn_sched_barrier(0);
      }
    }
  };
  __syncthreads();
  gload(kt0, rkA, rvA); lstore(0, rkA, rvA);
  if (nt > 1) gload(kt0 + 1, rkB, rvB);
  LDS_BARRIER();
  for (int t = 0; t < nt; t += 2) {
    if (t + 2 < nt) gload(kt0 + t + 2, rkA, rvA);
    compute(t, 0);
    if (t + 1 < nt) lstore(1, rkB, rvB);
    LDS_BARRIER();
    if (t + 1 >= nt) break;
    if (t + 3 < nt) gload(kt0 + t + 3, rkB, rvB);
    compute(t + 1, 1);
    if (t + 2 < nt) lstore(0, rkA, rvA);
    LDS_BARRIER();
  }
  __syncthreads();
  const size_t trow = (size_t)b * S + q0w + l32;
  const u16* grow = (const u16*)(p.ws + OFF_H) + trow * DIN + C_GATE + ocol;
  u16* orow = (u16*)(p.ws + OFF_OB) + trow * DM + ocol;
  float inv0 = 1.f / xchg_sum(l[0]);
  if (MODE == 1) {
    const float* lm = (const float*)(p.ws + OFF_LAM);
    const float lam = lm[layer], post = lm[4 + layer];
    const float inv1 = lam / xchg_sum(l[1]);
    float ss = 0.f;
#pragma unroll
    for (int dt = 0; dt < 2; ++dt)
#pragma unroll
      for (int r = 0; r < 16; ++r) { float v = O[0][dt][r] * inv0 - O[NMAP - 1][dt][r] * inv1; O[0][dt][r] = v; ss += v * v; }
    ss = xchg_sum(ss);
    inv0 = rsqrtf(ss * (1.f / 64.f) + 1e-6f) * post;
  }
#pragma unroll
  for (int dt = 0; dt < 2; ++dt)
#pragma unroll
    for (int g = 0; g < 4; ++g) {
      const int d = 32 * dt + 8 * g + 4 * hh;
      u32x2 gw = *(const u32x2*)(grow + d);
      float v0 = O[0][dt][4 * g + 0] * inv0, v1 = O[0][dt][4 * g + 1] * inv0, v2 = O[0][dt][4 * g + 2] * inv0, v3 = O[0][dt][4 * g + 3] * inv0;
      if (MODE == 1) { const float* sl = p.subln + layer * 64 + d; v0 *= sl[0]; v1 *= sl[1]; v2 *= sl[2]; v3 *= sl[3]; }
      v0 *= bflo(gw[0]); v1 *= bfhi(gw[0]); v2 *= bflo(gw[1]); v3 *= bfhi(gw[1]);
      u32x2 ow = {pk2(v0, v1), pk2(v2, v3)};
#ifdef PROBE_ZERO_MODE
      if (MODE == PROBE_ZERO_MODE) { ow[0] = 0u; ow[1] = 0u; }
#endif
      *(u32x2*)(orow + d) = ow;
    }
}

DI void phase_attn(const Params& p, int layer, char* lds) {
  constexpr int N_MLA = 24 * 32, N_DIFF = 16 * 32, N_SWA = 24 * 32;
  for (int g = blockIdx.x; g < N_MLA + N_DIFF + N_SWA; g += gridDim.x) {
    if (g < N_MLA) { int i = g; attn_item<0>(p, layer, (i & 7) + 8 * (i >> 8), (i >> 3) & 31, lds); }
    else if (g < N_MLA + N_DIFF) { int i = g - N_MLA; attn_item<1>(p, layer, (i & 7) + 8 * (i >> 8), (i >> 3) & 31, lds); }
    else { int i = g - N_MLA - N_DIFF; attn_item<2>(p, layer, (i & 7) + 8 * (i >> 8), (i >> 3) & 31, lds); }
  }
}

DI void phase_outproj(const Params& p, int layer, char* lds) {
  const u16* ob = (const u16*)(p.ws + OFF_OB);
  const u16* wt = (const u16*)(p.ws + OFF_WOUT) + (size_t)layer * DM * DM;
  const float* xres = layer == 0 ? p.x : p.out;
  float* xout = p.out;
  int tid_ = threadIdx.x; asm volatile("" : "+v"(tid_)); const int tid = tid_, lane = tid & 63, w = tid >> 6, l32 = lane & 31, hh = lane >> 5, wm = w & 1, wn = w >> 1;
  constexpr int NTN = DM / 256, NRB = T / 256, NTILES = NRB * NTN;
  const bool xcd_ok = (gridDim.x % 8) == 0;
  const int xj = xcd_ok ? (int)(blockIdx.x & 7) : 0, nbl = xcd_ok ? (int)(gridDim.x >> 3) : (int)gridDim.x;
  const int bl = xcd_ok ? (int)(blockIdx.x >> 3) : (int)blockIdx.x, per_x = xcd_ok ? NTILES / 8 : NTILES;
  for (int u = bl; u < per_x; u += nbl) {
    const int lr = u / NTN, nt = u % NTN, mt = xcd_ok ? lr * 8 + xj : lr, m0 = mt * 256, n0 = nt * 256;
    const int wr8 = w >> 2, wc8 = w & 3, fr = lane & 15, fq = lane >> 4;
    const size_t base = (size_t)(m0 + wr8 * 64 + fq * 4) * DM + (n0 + wc8 * 32 + fr);
    f32x4 acc[2][2][4][2];
#pragma unroll
    for (int ai = 0; ai < 2; ++ai)
#pragma unroll
      for (int bj = 0; bj < 2; ++bj)
#pragma unroll
        for (int m = 0; m < 4; ++m)
#pragma unroll
          for (int n = 0; n < 2; ++n) acc[ai][bj][m][n] = (f32x4){0.f, 0.f, 0.f, 0.f};
    gemm8p(ob, wt, m0, n0, acc);
    u16* yo = (u16*)(p.ws + OFF_XB) + base;
#pragma unroll
    for (int ai = 0; ai < 2; ++ai)
#pragma unroll
      for (int bj = 0; bj < 2; ++bj)
#pragma unroll
        for (int m = 0; m < 4; ++m) {
#pragma unroll
          for (int n = 0; n < 2; ++n)
#pragma unroll
            for (int j = 0; j < 4; ++j) yo[(ai * 128 + m * 16 + j) * DM + bj * 128 + n * 16] = f2bf(acc[ai][bj][m][n][j]);
          __builtin_amdgcn_sched_barrier(0);
        }
  }
}

DI void phase_ln(const Params& p, int layer) {
  const float* xres = layer == 0 ? p.x : p.out;
  float* xout = p.out;
  u16* xb = (u16*)(p.ws + OFF_XB);
  const float* lg = p.ln_g + layer * DM; const float* lb = p.ln_b + layer * DM;
  int tid_ = threadIdx.x; asm volatile("" : "+v"(tid_)); const int tid = tid_, lane = tid & 63, w = tid >> 6;
#pragma unroll 1
  for (size_t row = (size_t)blockIdx.x * 8 + w; row < (size_t)T; row += (size_t)gridDim.x * 8) {
    f32x4 v[4]; float sum = 0.f;
#pragma unroll
    for (int i = 0; i < 4; ++i) {
      const f32x4 xv = *(const f32x4*)(xres + row * DM + 4 * lane + 256 * i);
      const u32x2 yw = *(const u32x2*)(xb + row * DM + 4 * lane + 256 * i);
      v[i][0] = ALPHA * xv[0] + bflo(yw[0]); v[i][1] = ALPHA * xv[1] + bfhi(yw[0]); v[i][2] = ALPHA * xv[2] + bflo(yw[1]); v[i][3] = ALPHA * xv[3] + bfhi(yw[1]);
      sum += v[i][0] + v[i][1] + v[i][2] + v[i][3];
    }
    const float mu = wave_sum(sum) * (1.f / DM);
    float sq = 0.f;
#pragma unroll
    for (int i = 0; i < 4; ++i)
#pragma unroll
      for (int j = 0; j < 4; ++j) { float d = v[i][j] - mu; sq += d * d; }
    const float rstd = rsqrtf(wave_sum(sq) * (1.f / DM) + 1e-5f);
#pragma unroll
    for (int i = 0; i < 4; ++i) {
      const int col = 4 * lane + 256 * i;
      f32x4 g = *(const f32x4*)(lg + col), bb = *(const f32x4*)(lb + col), o;
#pragma unroll
      for (int j = 0; j < 4; ++j) o[j] = (v[i][j] - mu) * rstd * g[j] + bb[j];
      *(f32x4*)(xout + row * DM + col) = o;
      if (layer + 1 < DEPTH) {
        u32x2 ow = {pk2(o[0], o[1]), pk2(o[2], o[3])};
        *(u32x2*)(xb + row * DM + col) = ow;
      }
    }
  }
}

#if MK_COOP
DI void fast_grid_sync(unsigned* ctr, unsigned& epoch) {
  asm volatile("s_waitcnt vmcnt(0) lgkmcnt(0)" ::: "memory");
  __syncthreads();
  epoch += 1u;
  if (threadIdx.x == 0) {
    __builtin_amdgcn_fence(__ATOMIC_RELEASE, "agent");
    asm volatile("s_waitcnt vmcnt(0)" ::: "memory");
    const unsigned target = epoch * gridDim.x;
    (void)__hip_atomic_fetch_add(ctr, 1u, __ATOMIC_RELAXED, __HIP_MEMORY_SCOPE_AGENT);
    unsigned spins = 0;
    while (__hip_atomic_load(ctr, __ATOMIC_RELAXED, __HIP_MEMORY_SCOPE_AGENT) < target) {
      __builtin_amdgcn_s_sleep(2);
      if (++spins > (1u << 26)) break;
    }
    __builtin_amdgcn_fence(__ATOMIC_ACQUIRE, "agent");
    asm volatile("s_waitcnt vmcnt(0)" ::: "memory");
  }
  __syncthreads();
}

__global__ void __launch_bounds__(NTHR) fwd_megakernel(Params p) {
  char* lds = lds_dyn;
  cg::grid_group grid = cg::this_grid();
  unsigned* bar_ctr = (unsigned*)(p.ws + OFF_BAR); unsigned bar_epoch = 0;
  phase_prep(p, lds);
  grid.sync();
  for (int layer = 0; layer < DEPTH; ++layer) {
    phase_inproj(p, layer, lds);
    fast_grid_sync(bar_ctr, bar_epoch);
    phase_mla_up(p, layer, lds);
    fast_grid_sync(bar_ctr, bar_epoch);
#ifdef PROBE_REP_P12
    phase_inproj(p, layer, lds);
    fast_grid_sync(bar_ctr, bar_epoch);
    phase_mla_up(p, layer, lds);
    fast_grid_sync(bar_ctr, bar_epoch);
#endif
#ifdef PROBE_REP_P2
    phase_mla_up(p, layer, lds);
    fast_grid_sync(bar_ctr, bar_epoch);
#endif
    phase_attn(p, layer, lds);
#ifdef PROBE_REP_ATTN
    fast_grid_sync(bar_ctr, bar_epoch);
    phase_attn(p, layer, lds);
#endif
    fast_grid_sync(bar_ctr, bar_epoch);
    phase_outproj(p, layer, lds);
    fast_grid_sync(bar_ctr, bar_epoch);
    phase_ln(p, layer);
    if (layer + 1 < DEPTH) fast_grid_sync(bar_ctr, bar_epoch);
  }
}
#else
template <int PH>
__global__ void __launch_bounds__(NTHR, 2) phase_kernel(Params p, int layer) {
  __shared__ __attribute__((aligned(16))) char lds[LDS_BYTES];
  if (PH == 0) phase_prep(p, lds);
  if (PH == 1) phase_inproj(p, layer, lds);
  if (PH == 2) phase_mla_up(p, layer, lds);
  if (PH == 3) phase_attn(p, layer, lds);
  if (PH == 4) phase_outproj(p, layer, lds);
  if (PH == 5) phase_ln(p, layer);
}
#endif

extern "C" void kernel_launch(void* const* d_in, const int* in_sizes, int n_in, void* d_out, int out_size, void* d_ws, size_t ws_size,
                              hipStream_t stream) {
  if (n_in != 13 || ws_size < WS_END || out_size != T * DM) {
    fprintf(stderr, "kernel_launch: unexpected shapes n_in %d ws %zu (need %zu) out %d\n", n_in, ws_size, WS_END, out_size);
    return;
  }
  Params p{};
  p.x = (const float*)d_in[0]; p.w_in = (const float*)d_in[1]; p.qn = (const float*)d_in[2]; p.kvn = (const float*)d_in[3];
  p.w_uq = (const float*)d_in[4]; p.w_ukv = (const float*)d_in[5]; p.lamv = (const float*)d_in[6]; p.subln = (const float*)d_in[7];
  p.sink = (const float*)d_in[8]; p.relb = (const float*)d_in[9]; p.w_out = (const float*)d_in[10]; p.ln_g = (const float*)d_in[11];
  p.ln_b = (const float*)d_in[12]; p.out = (float*)d_out; p.ws = (char*)d_ws;
#if MK_COOP
  static int grid_blocks = 0;
  if (!grid_blocks) {
    int dev = 0, cus = 0, per_cu = 0;
    hipGetDevice(&dev);
    hipDeviceGetAttribute(&cus, hipDeviceAttributeMultiprocessorCount, dev);
    if (hipFuncSetAttribute((const void*)fwd_megakernel, hipFuncAttributeMaxDynamicSharedMemorySize, LDS_BYTES) != hipSuccess)
      fprintf(stderr, "kernel_launch: hipFuncSetAttribute(%d B dynamic LDS) failed\n", LDS_BYTES);
    hipOccupancyMaxActiveBlocksPerMultiprocessor(&per_cu, fwd_megakernel, NTHR, LDS_BYTES);
    (void)hipGetLastError();
    (void)per_cu;
    grid_blocks = cus;
  }
  (void)hipMemsetAsync((char*)d_ws + OFF_BAR, 0, 256, stream);
  void* args[] = {&p};
  hipError_t e = hipLaunchCooperativeKernel((void*)fwd_megakernel, dim3(grid_blocks), dim3(NTHR), args, LDS_BYTES, stream);
  if (e != hipSuccess) fprintf(stderr, "cooperative launch failed: %s (grid %d)\n", hipGetErrorString(e), grid_blocks);
#else
  const int G = 512;
  hipLaunchKernelGGL(phase_kernel<0>, dim3(G), dim3(NTHR), 0, stream, p, 0);
  for (int l = 0; l < DEPTH; ++l) {
    hipLaunchKernelGGL(phase_kernel<1>, dim3(G), dim3(NTHR), 0, stream, p, l);
    hipLaunchKernelGGL(phase_kernel<2>, dim3(G), dim3(NTHR), 0, stream, p, l);
    hipLaunchKernelGGL(phase_kernel<3>, dim3(G), dim3(NTHR), 0, stream, p, l);
    hipLaunchKernelGGL(phase_kernel<4>, dim3(G), dim3(NTHR), 0, stream, p, l);
    hipLaunchKernelGGL(phase_kernel<5>, dim3(G), dim3(NTHR), 0, stream, p, l);
  }
#endif
}
```

```cpp
#include <hip/hip_runtime.h>
#include <hip/hip_cooperative_groups.h>
#include <cstdio>
#include <cstdint>
namespace cg = cooperative_groups;

#ifndef MK_COOP
#define MK_COOP 1
#endif

#define DI __device__ __forceinline__
typedef unsigned short u16;
using bf16x8 = __attribute__((ext_vector_type(8))) short;
using s16x4  = __attribute__((ext_vector_type(4))) short;
using f32x16 = __attribute__((ext_vector_type(16))) float;
using f32x4  = __attribute__((ext_vector_type(4))) float;
using f32x2  = __attribute__((ext_vector_type(2))) float;
using u32x4  = __attribute__((ext_vector_type(4))) unsigned;
using u32x2  = __attribute__((ext_vector_type(2))) unsigned;
using b16x2  = __attribute__((ext_vector_type(2))) __bf16;
#define MFMA(a, b, c) __builtin_amdgcn_mfma_f32_32x32x16_bf16((a), (b), (c), 0, 0, 0)

constexpr int NB = 4, S = 8192, T = NB * S, DM = 1024, DIN = 2784, DEPTH = 4;
constexpr int C_CQ = 0, C_CKV = 192, C_KR = 320, C_DQ = 352, C_DK = 608, C_DV = 864, C_SQ = 1120, C_SK = 1504, C_SV = 1632, C_GATE = 1760;
constexpr int QW = 576, KW = 576, VW = 384;
constexpr float LOG2E = 1.4426950408889634f;
constexpr float ALPHA = 1.681792830507429f;
constexpr int NTHR = 512;
constexpr float PSLIM = 4096.0f;

constexpr size_t SZ_WIN = (size_t)DEPTH * DIN * DM * 2, SZ_WOUT = (size_t)DEPTH * DM * DM * 2;
constexpr size_t SZ_WUQ = (size_t)DEPTH * 576 * 192 * 2, SZ_WUKV = (size_t)DEPTH * 768 * 128 * 2;
constexpr size_t SZ_ROPE = (size_t)S * 16 * 8, SZ_LAM = 256;
constexpr size_t SZ_XB = (size_t)T * DM * 2, SZ_H = (size_t)T * DIN * 2, SZ_QB = (size_t)T * QW * 2, SZ_KB = (size_t)T * KW * 2;
constexpr size_t SZ_VB = (size_t)T * VW * 2, SZ_OB = (size_t)T * DM * 2, SZ_DK = (size_t)T * 256 * 2, SZ_SK = (size_t)T * 128 * 2;
constexpr size_t OFF_WIN = 0, OFF_WOUT = OFF_WIN + SZ_WIN, OFF_WUQ = OFF_WOUT + SZ_WOUT, OFF_WUKV = OFF_WUQ + SZ_WUQ;
constexpr size_t OFF_ROPE = OFF_WUKV + SZ_WUKV, OFF_LAM = OFF_ROPE + SZ_ROPE, OFF_XB = OFF_LAM + SZ_LAM, OFF_H = OFF_XB + SZ_XB;
constexpr size_t OFF_QB = OFF_H + SZ_H, OFF_KB = OFF_QB + SZ_QB, OFF_VB = OFF_KB + SZ_KB, OFF_OB = OFF_VB + SZ_VB, OFF_DK = OFF_OB + SZ_OB, OFF_DV = OFF_DK + SZ_DK, OFF_SK = OFF_DV + SZ_DK, OFF_SV = OFF_SK + SZ_SK, OFF_BAR = OFF_SV + SZ_SK, WS_END = OFF_BAR + 256;

struct Params {
  const float *x, *w_in, *qn, *kvn, *w_uq, *w_ukv, *lamv, *subln, *sink, *relb, *w_out, *ln_g, *ln_b;
  float* out;
  char* ws;
};

extern __shared__ __attribute__((aligned(16))) char lds_dyn[];
constexpr int LDS_BYTES = 147456;

DI u16 f2bf(float x) { unsigned u = __float_as_uint(x); u += 0x7fffu + ((u >> 16) & 1u); return (u16)(u >> 16); }
DI float bf2f(u16 b) { return __uint_as_float(((unsigned)b) << 16); }
DI unsigned pk2(float lo, float hi) { f32x2 v = {lo, hi}; b16x2 r = __builtin_convertvector(v, b16x2); return __builtin_bit_cast(unsigned, r); }
DI float bflo(unsigned w) { return __uint_as_float(w << 16); }
DI float bfhi(unsigned w) { return __uint_as_float(w & 0xffff0000u); }
DI int crow(int r, int hh) { return (r & 3) + 8 * (r >> 2) + 4 * hh; }
DI float xchg_max(float v) {
  auto rr = __builtin_amdgcn_permlane32_swap(__float_as_uint(v), __float_as_uint(v), false, false);
  return fmaxf(__uint_as_float(rr[0]), __uint_as_float(rr[1]));
}
DI float xchg_sum(float v) {
  auto rr = __builtin_amdgcn_permlane32_swap(__float_as_uint(v), __float_as_uint(v), false, false);
  return __uint_as_float(rr[0]) + __uint_as_float(rr[1]);
}
DI float wave_sum(float v) {
  for (int o = 32; o >= 1; o >>= 1) v += __shfl_xor(v, o);
  return v;
}
DI int t5_bucket(int rel) {
  int n = rel < 0 ? -rel : rel;
  int b;
  if (n < 8) b = n;
  else b = 8 + (n >= 12) + (n >= 16) + (n >= 23) + (n >= 32) + (n >= 46) + (n >= 64) + (n >= 91);
  return b + (rel > 0 ? 16 : 0);
}
DI bf16x8 pack8(const f32x16& x, int s8) {
  u32x4 p = {pk2(x[s8 + 0], x[s8 + 1]), pk2(x[s8 + 2], x[s8 + 3]), pk2(x[s8 + 4], x[s8 + 5]), pk2(x[s8 + 6], x[s8 + 7])};
  return __builtin_bit_cast(bf16x8, p);
}

__device__ __constant__ float ROPE_FREQ[16] = {
  1.0f, 0.5623413324356079f, 0.3162277638912201f, 0.17782793939113617f, 0.10000000149011612f, 0.05623413249850273f,
  0.03162277489900589f, 0.017782794311642647f, 0.009999999776482582f, 0.005623413249850273f, 0.003162277629598975f,
  0.0017782794311642647f, 0.0010000000474974513f, 0.000562341301701963f, 0.0003162277571391314f, 0.00017782794020604342f};

DI void prep_transpose_tile(const float* __restrict__ src, u16* __restrict__ dst, int R, int C, const float* __restrict__ g, int tr, int tc, float* lds) {
  int tid_ = threadIdx.x; asm volatile("" : "+v"(tid_)); const int tid = tid_;
  for (int i = tid; i < 4096; i += NTHR) {
    int r = i >> 6, c = i & 63, gr = tr * 64 + r, gc = tc * 64 + c;
    float v = 0.f;
    if (gr < R && gc < C) { v = src[(size_t)gr * C + gc]; if (g) v *= g[gr]; }
    lds[r * 65 + c] = v;
  }
  __syncthreads();
  for (int i = tid; i < 4096; i += NTHR) {
    int c = i >> 6, r = i & 63, gr = tr * 64 + r, gc = tc * 64 + c;
    if (gr < R && gc < C) dst[(size_t)gc * R + gr] = f2bf(lds[r * 65 + c]);
  }
  __syncthreads();
}

DI void sincos_d(double a, float& c, float& s) {
  const double TWO_PI = 6.283185307179586476925286766559, INV_TWO_PI = 0.15915494309189533576888376337251;
  double n = rint(a * INV_TWO_PI);
  double r = fma(-n, TWO_PI, a);
  r = fma(-n, 2.4492935982947064e-16, r);
  double r2 = r * r;
  double sp = 1.0 / 15511210043330985984000000.0;
  sp = fma(sp, r2, -1.0 / 25852016738884976640000.0);
  sp = fma(sp, r2, 1.0 / 51090942171709440000.0);
  sp = fma(sp, r2, -1.0 / 121645100408832000.0);
  sp = fma(sp, r2, 1.0 / 355687428096000.0);
  sp = fma(sp, r2, -1.0 / 1307674368000.0);
  sp = fma(sp, r2, 1.0 / 6227020800.0);
  sp = fma(sp, r2, -1.0 / 39916800.0);
  sp = fma(sp, r2, 1.0 / 362880.0);
  sp = fma(sp, r2, -1.0 / 5040.0);
  sp = fma(sp, r2, 1.0 / 120.0);
  sp = fma(sp, r2, -1.0 / 6.0);
  sp = fma(sp, r2, 1.0);
  double cp = 1.0 / 620448401733239439360000.0;
  cp = fma(cp, r2, -1.0 / 1124000727777607680000.0);
  cp = fma(cp, r2, 1.0 / 2432902008176640000.0);
  cp = fma(cp, r2, -1.0 / 6402373705728000.0);
  cp = fma(cp, r2, 1.0 / 20922789888000.0);
  cp = fma(cp, r2, -1.0 / 87178291200.0);
  cp = fma(cp, r2, 1.0 / 479001600.0);
  cp = fma(cp, r2, -1.0 / 3628800.0);
  cp = fma(cp, r2, 1.0 / 40320.0);
  cp = fma(cp, r2, -1.0 / 720.0);
  cp = fma(cp, r2, 1.0 / 24.0);
  cp = fma(cp, r2, -0.5);
  cp = fma(cp, r2, 1.0);
  s = (float)(sp * r); c = (float)cp;
}

DI void phase_prep(const Params& p, char* lds) {
  u16* wt_in = (u16*)(p.ws + OFF_WIN); u16* wt_out = (u16*)(p.ws + OFF_WOUT);
  u16* wt_uq = (u16*)(p.ws + OFF_WUQ); u16* wt_ukv = (u16*)(p.ws + OFF_WUKV);
  constexpr int N_IN = 16 * 44, N_OUT = 16 * 16, N_UQ = 3 * 9, N_UKV = 2 * 12;
  constexpr int PER_L = N_IN + N_OUT + N_UQ + N_UKV;
  for (int it = blockIdx.x; it < DEPTH * PER_L; it += gridDim.x) {
    int l = it / PER_L, j = it % PER_L;
    if (j < N_IN) prep_transpose_tile(p.w_in + (size_t)l * DM * DIN, wt_in + (size_t)l * DIN * DM, DM, DIN, nullptr, j / 44, j % 44, (float*)lds);
    else if ((j -= N_IN) < N_OUT) prep_transpose_tile(p.w_out + (size_t)l * DM * DM, wt_out + (size_t)l * DM * DM, DM, DM, nullptr, j / 16, j % 16, (float*)lds);
    else if ((j -= N_OUT) < N_UQ) prep_transpose_tile(p.w_uq + (size_t)l * 192 * 576, wt_uq + (size_t)l * 576 * 192, 192, 576, p.qn + l * 192, j / 9, j % 9, (float*)lds);
    else { j -= N_UQ; prep_transpose_tile(p.w_ukv + (size_t)l * 128 * 768, wt_ukv + (size_t)l * 768 * 128, 128, 768, p.kvn + l * 128, j / 12, j % 12, (float*)lds); }
  }
  const size_t gtid = (size_t)blockIdx.x * NTHR + threadIdx.x, gsz = (size_t)gridDim.x * NTHR;
  u16* xb = (u16*)(p.ws + OFF_XB);
  for (size_t i = gtid; i < (size_t)T * DM / 8; i += gsz) {
    f32x4 a = *(const f32x4*)(p.x + i * 8), b = *(const f32x4*)(p.x + i * 8 + 4);
    u32x4 o = {pk2(a[0], a[1]), pk2(a[2], a[3]), pk2(b[0], b[1]), pk2(b[2], b[3])};
    *(u32x4*)(xb + i * 8) = o;
  }
  f32x2* rt = (f32x2*)(p.ws + OFF_ROPE);
  for (size_t i = gtid; i < (size_t)S * 16; i += gsz) {
    int pos = (int)(i >> 4), k = (int)(i & 15);
    float ang = (float)pos * ROPE_FREQ[k];
    float c, s; sincos_d((double)ang, c, s);
    f32x2 v = {c, s}; rt[i] = v;
  }
  if (blockIdx.x == 0 && threadIdx.x < DEPTH) {
    int l = threadIdx.x; const float* lv = p.lamv + l * 128;
    float d1 = 0.f, d2 = 0.f;
    for (int i = 0; i < 32; ++i) { d1 += lv[i] * lv[32 + i]; d2 += lv[64 + i] * lv[96 + i]; }
    float lam_init = 0.8f - 0.6f * expf(-0.3f * (float)l);
    float* lm = (float*)(p.ws + OFF_LAM);
    lm[l] = expf(d1) - expf(d2) + lam_init;
    lm[4 + l] = 1.0f - lam_init;
  }
}

#define LDS_BARRIER() asm volatile("s_waitcnt lgkmcnt(0)\n\ts_barrier" ::: "memory")
DI void gemm256(const u16* __restrict__ A, int lda, const u16* __restrict__ Bt, int ldb, int m0, int n0, int nvalid, int K,
                char* lds, f32x16 (&acc)[4][2], const float* cinit = nullptr) {
  constexpr int ASZ = 256 * 144, STG = 2 * ASZ;
  int tid_ = threadIdx.x; asm volatile("" : "+v"(tid_)); const int tid = tid_, lane = tid & 63, w = tid >> 6, l32 = lane & 31, hh = lane >> 5, wm = w & 1, wn = w >> 1;
  if (cinit) {
    const float* cp = cinit + (size_t)(m0 + 128 * wm + 4 * hh) * DM + (n0 + 64 * wn + l32);
#pragma unroll
    for (int mi = 0; mi < 4; ++mi)
#pragma unroll
      for (int ni = 0; ni < 2; ++ni)
#pragma unroll
        for (int r = 0; r < 16; ++r) acc[mi][ni][r] = ALPHA * cp[(32 * mi + (r & 3) + 8 * (r >> 2)) * DM + 32 * ni];
  } else {
#pragma unroll
    for (int mi = 0; mi < 4; ++mi)
#pragma unroll
      for (int ni = 0; ni < 2; ++ni)
#pragma unroll
        for (int r = 0; r < 16; ++r) acc[mi][ni][r] = 0.f;
  }
  u32x4 ra[4], rb[4];
  const int KT = K / 64;
  const int lrow = tid >> 3, lch = tid & 7;
  const u16* ap = A + (size_t)(m0 + lrow) * lda + lch * 8;
  const u16* bp = Bt + (size_t)(n0 + lrow) * ldb + lch * 8;
  auto gload = [&](int kt) {
#pragma unroll
    for (int i = 0; i < 4; ++i) ra[i] = *(const u32x4*)(ap + (size_t)(64 * i) * lda + kt * 64);
#pragma unroll
    for (int i = 0; i < 4; ++i) { u32x4 z = {0u, 0u, 0u, 0u};
      rb[i] = (lrow + 64 * i < nvalid) ? *(const u32x4*)(bp + (size_t)(64 * i) * ldb + kt * 64) : z; }
  };
  auto lstore = [&](int st) {
    char* As = lds + st * STG + lrow * 144 + lch * 16;
#pragma unroll
    for (int i = 0; i < 4; ++i) *(u32x4*)(As + 64 * i * 144) = ra[i];
#pragma unroll
    for (int i = 0; i < 4; ++i) *(u32x4*)(As + ASZ + 64 * i * 144) = rb[i];
  };
  auto compute = [&](int st) {
    const char* As = lds + st * STG + (128 * wm + l32) * 144 + hh * 16;
    const char* Bs = lds + st * STG + ASZ + (64 * wn + l32) * 144 + hh * 16;
    bf16x8 a0[4], b0[2], a1[4], b1[2];
#define LDFRAG(K16, AF, BF) do { _Pragma("unroll") for (int mi = 0; mi < 4; ++mi) AF[mi] = *(const bf16x8*)(As + 32 * mi * 144 + (K16) * 32); \
    _Pragma("unroll") for (int ni = 0; ni < 2; ++ni) BF[ni] = *(const bf16x8*)(Bs + 32 * ni * 144 + (K16) * 32); } while (0)
#define MMSTEP(AF, BF) do { _Pragma("unroll") for (int mi = 0; mi < 4; ++mi) _Pragma("unroll") for (int ni = 0; ni < 2; ++ni) acc[mi][ni] = MFMA(AF[mi], BF[ni], acc[mi][ni]); } while (0)
#define SGB(mask, n) __builtin_amdgcn_sched_group_barrier(mask, n, 0)
#define PIPE_STEP() do { SGB(0x100, 1); SGB(0x008, 1); SGB(0x100, 1); SGB(0x008, 1); SGB(0x100, 1); SGB(0x008, 1); SGB(0x100, 1); SGB(0x008, 1); \
    SGB(0x100, 1); SGB(0x008, 1); SGB(0x100, 1); SGB(0x008, 1); SGB(0x008, 2); } while (0)
    LDFRAG(0, a0, b0);
    LDFRAG(1, a1, b1); MMSTEP(a0, b0);
    LDFRAG(2, a0, b0); MMSTEP(a1, b1);
    LDFRAG(3, a1, b1); MMSTEP(a0, b0);
    MMSTEP(a1, b1);
    __builtin_amdgcn_iglp_opt(1);
#undef LDFRAG
#undef MMSTEP
#undef PIPE_STEP
  };
  gload(0); lstore(0);
  LDS_BARRIER();
  for (int kt = 0; kt < KT; ++kt) {
    if (kt + 1 < KT) gload(kt + 1);
    compute(kt & 1);
    if (kt + 1 < KT) lstore((kt + 1) & 1);
    LDS_BARRIER();
  }
}

DI int g8_lds_byte(int r, int c) { int st = (r >> 4) * 2 + (c >> 5), rr = r & 15, cc = c & 31, ob = rr * 64 + cc * 2; return st * 1024 + (ob ^ (((ob >> 9) & 1) << 5)); }
DI void g8_stage_rc(int b, int& R, int& C) { int st = b / 1024, sb = b % 1024, swz = sb ^ (((sb >> 9) & 1) << 5); R = (st >> 1) * 16 + swz / 64; C = (st & 1) * 32 + (swz % 64) / 2; }
DI void gemm8p(const u16* __restrict__ A, const u16* __restrict__ Bt, int brow, int bcol, f32x4 (&acc)[2][2][4][2]) {
  constexpr int K = 1024, BK = 64, HALF = 128, HT = HALF * BK;
  u16* shm = (u16*)lds_dyn;
#define G8_SA(b, h) (shm + ((b) * 2 + (h)) * HT)
#define G8_SB(b, h) (shm + (4 + (b) * 2 + (h)) * HT)
#define G8_STAGE(P, BASE, br, kt) do { const u16* gb_ = (BASE) + ((long)(br) * K + (long)(kt) * BK);     \
      __builtin_amdgcn_global_load_lds((const unsigned*)(gb_ + soff0), (__attribute__((address_space(3))) unsigned*)((char*)(P) + tid8 * 16), 16, 0, 0); \
      __builtin_amdgcn_global_load_lds((const unsigned*)(gb_ + soff1), (__attribute__((address_space(3))) unsigned*)((char*)(P) + tid8 * 16 + 8192), 16, 0, 0); } while (0)
#define G8_LDA(dst, b, h) for (int m = 0; m < 4; ++m) for (int k = 0; k < 2; ++k) \
    dst[m][k] = *reinterpret_cast<const bf16x8*>((char*)G8_SA(b, h) + g8_lds_byte(wr * 64 + m * 16 + fr, k * 32 + fq * 8))
#define G8_LDB(dst, b, h) for (int n = 0; n < 2; ++n) for (int k = 0; k < 2; ++k) \
    dst[n][k] = *reinterpret_cast<const bf16x8*>((char*)G8_SB(b, h) + g8_lds_byte(wc * 32 + n * 16 + fr, k * 32 + fq * 8))
#define G8_MMA(ai, bj, At_, Bt_) do { __builtin_amdgcn_s_setprio(1); \
    for (int m = 0; m < 4; ++m) for (int n = 0; n < 2; ++n) for (int k = 0; k < 2; ++k) \
      acc[ai][bj][m][n] = __builtin_amdgcn_mfma_f32_16x16x32_bf16(At_[m][k], Bt_[n][k], acc[ai][bj][m][n], 0, 0, 0); \
    __builtin_amdgcn_s_setprio(0); } while (0)
#define G8_WV(n) asm volatile("s_waitcnt vmcnt(" #n ")" ::: "memory")
#define G8_WL(n) asm volatile("s_waitcnt lgkmcnt(" #n ")" ::: "memory")
#define G8_BAR __builtin_amdgcn_s_barrier()
#define G8_SCHED __builtin_amdgcn_sched_barrier(0)
  int tid8 = threadIdx.x; asm volatile("" : "+v"(tid8));
  const int wid = tid8 >> 6, lane = tid8 & 63, wr = wid >> 2, wc = wid & 3, fr = lane & 15, fq = lane >> 4;
  int soff0, soff1;
  { int r_, c_; g8_stage_rc(tid8 * 16, r_, c_); soff0 = r_ * K + c_; g8_stage_rc(tid8 * 16 + 8192, r_, c_); soff1 = r_ * K + c_; }
  bf16x8 At[4][2], B0[2][2], B1[2][2];
  constexpr int nt = K / BK;
  __syncthreads();
  G8_STAGE(G8_SB(0, 0), Bt, bcol, 0); G8_STAGE(G8_SA(0, 0), A, brow, 0);
  G8_STAGE(G8_SB(0, 1), Bt, bcol + HALF, 0); G8_STAGE(G8_SA(0, 1), A, brow + HALF, 0);
  if (wr == 1) G8_BAR;
  G8_WV(4); G8_BAR;
  G8_STAGE(G8_SB(1, 0), Bt, bcol, 1); G8_STAGE(G8_SA(1, 0), A, brow, 1); G8_STAGE(G8_SB(1, 1), Bt, bcol + HALF, 1);
  G8_WV(6); G8_BAR;
#pragma unroll 1
  for (int t = 0; t < nt - 2; t += 2) {
    G8_LDB(B0, 0, 0); G8_SCHED; G8_LDA(At, 0, 0); G8_STAGE(G8_SA(1, 1), A, brow + HALF, t + 1);
    G8_WL(8); G8_BAR; G8_WL(0); G8_MMA(0, 0, At, B0); G8_BAR; G8_SCHED;
    G8_LDB(B1, 0, 1); G8_STAGE(G8_SB(0, 0), Bt, bcol, t + 2);
    G8_BAR; G8_WL(0); G8_MMA(0, 1, At, B1); G8_BAR;
    G8_LDA(At, 0, 1); G8_STAGE(G8_SA(0, 0), A, brow, t + 2);
    G8_BAR; G8_WL(0); G8_MMA(1, 0, At, B0); G8_BAR; G8_SCHED;
    G8_STAGE(G8_SB(0, 1), Bt, bcol + HALF, t + 2);
    G8_WV(6); G8_BAR; G8_MMA(1, 1, At, B1); G8_BAR;
    G8_LDB(B0, 1, 0); G8_SCHED; G8_LDA(At, 1, 0); G8_STAGE(G8_SA(0, 1), A, brow + HALF, t + 2);
    G8_WL(8); G8_BAR; G8_WL(0); G8_MMA(0, 0, At, B0); G8_BAR; G8_SCHED;
    G8_LDB(B1, 1, 1); G8_STAGE(G8_SB(1, 0), Bt, bcol, t + 3);
    G8_BAR; G8_WL(0); G8_MMA(0, 1, At, B1); G8_BAR;
    G8_LDA(At, 1, 1); G8_STAGE(G8_SA(1, 0), A, brow, t + 3);
    G8_BAR; G8_WL(0); G8_MMA(1, 0, At, B0); G8_BAR; G8_SCHED;
    G8_STAGE(G8_SB(1, 1), Bt, bcol + HALF, t + 3);
    G8_WV(6); G8_BAR; G8_MMA(1, 1, At, B1); G8_BAR;
  }
  { G8_LDB(B0, 0, 0); G8_LDA(At, 0, 0); G8_STAGE(G8_SA(1, 1), A, brow + HALF, nt - 1);
    G8_BAR; G8_WL(0); G8_MMA(0, 0, At, B0); G8_BAR;
    G8_LDB(B1, 0, 1); G8_BAR; G8_WL(0); G8_MMA(0, 1, At, B1); G8_BAR;
    G8_LDA(At, 0, 1); G8_WV(4); G8_BAR; G8_WL(0); G8_MMA(1, 0, At, B0); G8_MMA(1, 1, At, B1); G8_BAR; }
  { G8_LDB(B0, 1, 0); G8_LDA(At, 1, 0); G8_WV(2); G8_BAR; G8_WL(0); G8_MMA(0, 0, At, B0); G8_BAR;
    G8_LDB(B1, 1, 1); G8_WV(0); G8_BAR; G8_WL(0); G8_MMA(0, 1, At, B1); G8_BAR;
    G8_LDA(At, 1, 1); G8_BAR; G8_WL(0); G8_MMA(1, 0, At, B0); G8_MMA(1, 1, At, B1); G8_BAR; }
  if (wr == 0) G8_BAR;
#undef G8_SA
#undef G8_SB
#undef G8_STAGE
#undef G8_LDA
#undef G8_LDB
#undef G8_MMA
#undef G8_WV
#undef G8_WL
#undef G8_BAR
#undef G8_SCHED
}

DI void phase_inproj(const Params& p, int layer, char* lds) {
  const u16* xb = (const u16*)(p.ws + OFF_XB);
  const u16* wt = (const u16*)(p.ws + OFF_WIN) + (size_t)layer * DIN * DM;
  u16* H = (u16*)(p.ws + OFF_H);
  int tid_ = threadIdx.x; asm volatile("" : "+v"(tid_)); const int tid = tid_, lane = tid & 63, w = tid >> 6, l32 = lane & 31, hh = lane >> 5, wm = w & 1, wn = w >> 1;
  constexpr int NTN = 11, NRB = T / 256, NTILES = NRB * NTN;
  const float SC_DQ = 0.17677669529663687f * LOG2E, SC_SQ = 0.125f * LOG2E;
  const bool xcd_ok = (gridDim.x % 8) == 0;
  const int xj = xcd_ok ? (int)(blockIdx.x & 7) : 0, nbl = xcd_ok ? (int)(gridDim.x >> 3) : (int)gridDim.x;
  const int bl = xcd_ok ? (int)(blockIdx.x >> 3) : (int)blockIdx.x, per_x = xcd_ok ? NTILES / 8 : NTILES;
  for (int u = bl; u < per_x; u += nbl) {
    const int lr = u / NTN, nt = u % NTN;
    const int mt = xcd_ok ? lr * 8 + xj : lr, m0 = mt * 256, n0 = nt * 256;
    const int nvalid = (DIN - n0) < 256 ? (DIN - n0) : 256;
    (void)nvalid;
    f32x4 acc[2][2][4][2];
#pragma unroll
    for (int ai = 0; ai < 2; ++ai)
#pragma unroll
      for (int bj = 0; bj < 2; ++bj)
#pragma unroll
        for (int m = 0; m < 4; ++m)
#pragma unroll
          for (int n = 0; n < 2; ++n) acc[ai][bj][m][n] = (f32x4){0.f, 0.f, 0.f, 0.f};
    gemm8p(xb, wt, m0, n0, acc);
    const int wr8 = w >> 2, wc8 = w & 3, fr = lane & 15, fq = lane >> 4;
#pragma unroll
    for (int bj = 0; bj < 2; ++bj)
#pragma unroll
      for (int n = 0; n < 2; ++n) {
        const int cw = n0 + bj * 128 + wc8 * 32 + n * 16, col = cw + fr;
        u16* dst = H + cw; int dstr = DIN;
        {
          const int bb = m0 / S;
          if (cw >= C_DK && cw < C_DV) { const int o = cw - C_DK; dst = (u16*)(p.ws + OFF_DK) + ((size_t)(bb * 3 * S + (o >> 6) * S) << 6) + (o & 63); dstr = 64; }
          else if (cw >= C_DV && cw < C_SQ) { const int o = cw - C_DV; dst = (u16*)(p.ws + OFF_DV) + ((size_t)(bb * 3 * S + (o >> 6) * S) << 6) + (o & 63); dstr = 64; }
          else if (cw >= C_SK && cw < C_SV) { const int o = cw - C_SK; dst = (u16*)(p.ws + OFF_SK) + ((size_t)(bb * 1 * S + (o >> 6) * S) << 6) + (o & 63); dstr = 64; }
          else if (cw >= C_SV && cw < C_GATE) { const int o = cw - C_SV; dst = (u16*)(p.ws + OFF_SV) + ((size_t)(bb * 1 * S + (o >> 6) * S) << 6) + (o & 63); dstr = 64; }
        }
        if (cw < DIN) {
          float sc = 1.f;
          if (col >= C_DQ && col < C_DK) sc = SC_DQ;
          if (col >= C_SQ && col < C_SK) sc = SC_SQ;
          const bool gate = col >= C_GATE;
#pragma unroll
          for (int ai = 0; ai < 2; ++ai)
#pragma unroll
            for (int m = 0; m < 4; ++m) {
#pragma unroll
              for (int j = 0; j < 4; ++j) {
                const int row = m0 + ai * 128 + wr8 * 64 + m * 16 + fq * 4 + j;
                float v = acc[ai][bj][m][n][j] * sc;
                if (gate) v = v * __builtin_amdgcn_rcpf(1.f + __expf(-v));
                dst[(size_t)row * dstr + fr] = f2bf(v);
              }
              __builtin_amdgcn_sched_barrier(0);
            }
        }
      }
  }
}

DI void phase_mla_up(const Params& p, int layer, char* lds) {
  const u16* H = (const u16*)(p.ws + OFF_H);
  const u16* wuq = (const u16*)(p.ws + OFF_WUQ) + (size_t)layer * 576 * 192;
  const u16* wukv = (const u16*)(p.ws + OFF_WUKV) + (size_t)layer * 768 * 128;
  const f32x2* rt = (const f32x2*)(p.ws + OFF_ROPE);
  u16* QB = (u16*)(p.ws + OFF_QB); u16* KB = (u16*)(p.ws + OFF_KB); u16* VB = (u16*)(p.ws + OFF_VB);
  int tid_ = threadIdx.x; asm volatile("" : "+v"(tid_)); const int tid = tid_, lane = tid & 63, w = tid >> 6, l32 = lane & 31, hh = lane >> 5, wm = w & 3, wn = w >> 2;
  char* As = lds; char* Bs = lds + 128 * 400; float* rinv = (float*)(lds + 256 * 400);
  const float QSC = 0.10206207261596577f * LOG2E;
  for (int item = blockIdx.x; item < T / 128; item += gridDim.x) {
    const int m0 = item * 128;
#pragma unroll 1
    for (int part = 0; part < 2; ++part) {
      const int K = part == 0 ? 192 : 128, acol = part == 0 ? C_CQ : C_CKV, STR = (K + 8) * 2, CPR = K / 8;
      const int NCT = part == 0 ? 9 : 12;
      const u16* Wt = part == 0 ? wuq : wukv;
      __syncthreads();
      for (int c = tid; c < 128 * CPR; c += NTHR) { int row = c / CPR, ch = c % CPR;
        *(u32x4*)(As + row * STR + ch * 16) = *(const u32x4*)(H + (size_t)(m0 + row) * DIN + acol + ch * 8); }
      __syncthreads();
      {
        int row = tid >> 2, part4 = tid & 3, n = K / 4; float ss = 0.f;
        const u16* ar = (const u16*)(As + row * STR) + part4 * n;
        for (int i = 0; i < n; ++i) { float v = bf2f(ar[i]); ss += v * v; }
        ss += __shfl_xor(ss, 1); ss += __shfl_xor(ss, 2);
        if (part4 == 0) rinv[row] = rsqrtf(ss / (float)K + 1e-6f);
      }
      const int NCT2 = (NCT + 1) / 2, NOUT = NCT * 64;
      u32x4 rw[6];
      auto wload = [&](int ct) {
        int tl = tid; asm volatile("" : "+v"(tl));
#pragma unroll
        for (int i = 0; i < 6; ++i) { const int c = tl + NTHR * i; if (c < 128 * CPR) rw[i] = *(const u32x4*)(Wt + (size_t)ct * 128 * K + c * 8); }
      };
      __syncthreads();
      float rv[16];
#pragma unroll
      for (int r = 0; r < 16; ++r) rv[r] = rinv[32 * wm + crow(r, hh)] * (part == 0 ? QSC : 1.f);
      const int rowb = m0 + 32 * wm + 4 * hh;
      const int bq = m0 >> 13, srow = rowb & (S - 1);
      auto epi = [&](const f32x16& acc, const int c0) {
        if (part == 0) {
          const bool is_rope = (c0 % 96 == 64);
          u16* qp = QB + (size_t)rowb * QW + c0 + l32;
          const f32x2* rp = rt + (size_t)srow * 16 + (l32 & 15);
#pragma unroll
          for (int r = 0; r < 16; ++r) {
            const int ro = (r & 3) + 8 * (r >> 2);
            float v = acc[r] * rv[r];
            if (is_rope) {
              float o = __shfl_xor(v, 16);
              f32x2 cs = rp[ro * 16];
              v = (l32 < 16) ? (v * cs[0] - o * cs[1]) : (v * cs[0] + o * cs[1]);
            }
            qp[ro * QW] = (u16)(pk2(v, 0.f) & 0xffffu);
          }
        } else {
          const int head = c0 >> 7, within = c0 & 127;
          const size_t hrow = (size_t)(bq * 6 + head) * S + srow;
          if (within < 64) {
            u16* kp = KB + hrow * 96 + within + l32;
#pragma unroll
            for (int r = 0; r < 16; ++r) kp[((r & 3) + 8 * (r >> 2)) * 96] = (u16)(pk2(acc[r] * rv[r], 0.f) & 0xffffu);
          } else {
            u16* vp = VB + hrow * 64 + (within - 64) + l32;
#pragma unroll
            for (int r = 0; r < 16; ++r) vp[((r & 3) + 8 * (r >> 2)) * 64] = (u16)(pk2(acc[r] * rv[r], 0.f) & 0xffffu);
          }
        }
      };
      wload(0);
#pragma unroll 1
      for (int ct = 0; ct < NCT2; ++ct) {
        {
          int tl = tid; asm volatile("" : "+v"(tl));
#pragma unroll
          for (int i = 0; i < 6; ++i) { const int c = tl + NTHR * i, row = c / CPR, ch = c % CPR; if (c < 128 * CPR) *(u32x4*)(Bs + row * STR + ch * 16) = rw[i]; }
        }
        LDS_BARRIER();
        if (ct + 1 < NCT2) wload(ct + 1);
        f32x16 acc0, acc1;
#pragma unroll
        for (int r = 0; r < 16; ++r) { acc0[r] = 0.f; acc1[r] = 0.f; }
#define P2_MMA(NST, STRB) do { const char* ap_ = As + (32 * wm + l32) * (STRB) + hh * 16; const char* bp_ = Bs + (64 * wn + l32) * (STRB) + hh * 16; \
          _Pragma("unroll") for (int st = 0; st < (NST); ++st) { \
            bf16x8 af = *(const bf16x8*)(ap_ + st * 32); bf16x8 b0 = *(const bf16x8*)(bp_ + st * 32); bf16x8 b1 = *(const bf16x8*)(bp_ + 32 * (STRB) + st * 32); \
            acc0 = MFMA(af, b0, acc0); acc1 = MFMA(af, b1, acc1); } } while (0)
        if (part == 0) P2_MMA(12, 400); else P2_MMA(8, 272);
#undef P2_MMA
        const int c0 = ct * 128 + 64 * wn;
        if (c0 < NOUT) epi(acc0, c0);
        if (c0 + 32 < NOUT) epi(acc1, c0 + 32);
        LDS_BARRIER();
      }
    }
    for (int idx = tid; idx < 128 * 16; idx += NTHR) {
      const int row = idx >> 4, i = idx & 15, trow = m0 + row;
      float x1 = bf2f(H[(size_t)trow * DIN + C_KR + i]), x2 = bf2f(H[(size_t)trow * DIN + C_KR + 16 + i]);
      f32x2 cs = rt[(size_t)(trow & (S - 1)) * 16 + i];
      u16 o1 = f2bf(x1 * cs[0] - x2 * cs[1]), o2 = f2bf(x2 * cs[0] + x1 * cs[1]);
#pragma unroll
      for (int hd = 0; hd < 6; ++hd) { const size_t hrow = (size_t)((trow >> 13) * 6 + hd) * S + (trow & (S - 1)); KB[hrow * 96 + 64 + i] = o1; KB[hrow * 96 + 80 + i] = o2; }
    }
  }
}

constexpr int VSTR = 192;
template <int OFF>
DI void trread8(unsigned addr, s16x4 (&v)[8]) {
  asm volatile(
      "ds_read_b64_tr_b16 %0, %8 offset:%9\n\t"
      "ds_read_b64_tr_b16 %1, %8 offset:%10\n\t"
      "ds_read_b64_tr_b16 %2, %8 offset:%11\n\t"
      "ds_read_b64_tr_b16 %3, %8 offset:%12\n\t"
      "ds_read_b64_tr_b16 %4, %8 offset:%13\n\t"
      "ds_read_b64_tr_b16 %5, %8 offset:%14\n\t"
      "ds_read_b64_tr_b16 %6, %8 offset:%15\n\t"
      "ds_read_b64_tr_b16 %7, %8 offset:%16\n\t"
      "s_waitcnt lgkmcnt(0)"
      : "=&v"(v[0]), "=&v"(v[1]), "=&v"(v[2]), "=&v"(v[3]), "=&v"(v[4]), "=&v"(v[5]), "=&v"(v[6]), "=&v"(v[7])
      : "v"(addr), "i"(OFF + 0 * VSTR + 0), "i"(OFF + 8 * VSTR + 0), "i"(OFF + 0 * VSTR + 64), "i"(OFF + 8 * VSTR + 64),
        "i"(OFF + 16 * VSTR + 0), "i"(OFF + 24 * VSTR + 0), "i"(OFF + 16 * VSTR + 64), "i"(OFF + 24 * VSTR + 64)
      : "memory");
}

template <int MODE>
DI void attn_item(const Params& p, int layer, int bh, int qb, char* lds) {
  constexpr int KD = MODE == 0 ? 96 : 64, NMAP = MODE == 1 ? 2 : 1, QS = MODE == 0 ? 6 : (MODE == 1 ? 2 : 4);
  constexpr int KSTR = KD * 2 + 16, KBYTES = 64 * KSTR, VBYTES = 64 * VSTR, STAGE = KBYTES + VBYTES, KCH = (8 * KD + NTHR - 1) / NTHR, KCPR = KD / 8, KCHUNKS = 8 * KD;
  constexpr int BREL_BYTES = 2048;
  int tid_ = threadIdx.x; asm volatile("" : "+v"(tid_)); const int tid = tid_, lane = tid & 63, w = tid >> 6, l32 = lane & 31, hh = lane >> 5;
  const int q0 = qb * 256, q0w = q0 + 32 * w;
  const u16 *Qg, *Kg, *Vg; int qstr, kstr, vstr, ocol, b, hd;
  if (MODE == 0) {
    b = bh / 6; hd = bh % 6;
    Qg = (const u16*)(p.ws + OFF_QB) + (size_t)b * S * QW + hd * 96; qstr = QW;
    Kg = (const u16*)(p.ws + OFF_KB) + (size_t)(b * 6 + hd) * S * 96; kstr = 96;
    Vg = (const u16*)(p.ws + OFF_VB) + (size_t)(b * 6 + hd) * S * 64; vstr = 64;
    ocol = hd * 64;
  } else if (MODE == 1) {
    b = bh / 4; hd = bh % 4;
    const u16* Hb = (const u16*)(p.ws + OFF_H) + (size_t)b * S * DIN;
    Qg = Hb + C_DQ + hd * 64; qstr = DIN; kstr = vstr = 64;
    Kg = (const u16*)(p.ws + OFF_DK) + (size_t)(b * 4 + hd) * S * 64; Vg = (const u16*)(p.ws + OFF_DV) + (size_t)(b * 4 + hd) * S * 64;
    ocol = 384 + hd * 64;
  } else {
    b = bh / 6; hd = bh % 6;
    const u16* Hb = (const u16*)(p.ws + OFF_H) + (size_t)b * S * DIN;
    Qg = Hb + C_SQ + hd * 64; qstr = DIN; kstr = vstr = 64;
    Kg = (const u16*)(p.ws + OFF_SK) + (size_t)(b * 2 + hd / 3) * S * 64; Vg = (const u16*)(p.ws + OFF_SV) + (size_t)(b * 2 + hd / 3) * S * 64;
    ocol = 640 + hd * 64;
  }
  float* brel = (float*)lds;
  char* stage0 = lds + BREL_BYTES;
  if (MODE != 0) {
    const int bcol = MODE == 1 ? hd : 4 + hd;
    for (int i = tid; i < 512; i += NTHR) {
      int rel = i - 224, rc = rel < -128 ? -128 : (rel > 128 ? 128 : rel);
      float bv = p.relb[t5_bucket(rc) * 10 + bcol] * LOG2E;
      brel[i] = (MODE == 2 && rc != rel) ? -1e30f : bv;
    }
  }
  bf16x8 qf[NMAP][QS];
  {
    const u16* qrow = Qg + (size_t)(q0w + l32) * qstr + hh * 8;
#pragma unroll
    for (int mp = 0; mp < NMAP; ++mp)
#pragma unroll
      for (int st = 0; st < QS; ++st) qf[mp][st] = *(const bf16x8*)(qrow + (mp * QS + st) * 16);
  }
  f32x16 O[NMAP][2]; float m = 0.f, l[NMAP];
#pragma unroll
  for (int mp = 0; mp < NMAP; ++mp) {
#pragma unroll
    for (int r = 0; r < 16; ++r) { O[mp][0][r] = 0.f; O[mp][1][r] = 0.f; }
    l[mp] = 0.f;
  }
  if (MODE == 2) { m = p.sink[layer * 6 + hd] * LOG2E; l[0] = (hh == 0) ? 1.f : 0.f; }
  int kt0 = 0, kt1 = S / 64;
  if (MODE == 2) { kt0 = (q0 - 128) / 64; if (kt0 < 0) kt0 = 0; kt1 = (q0 + 384) / 64; if (kt1 > S / 64) kt1 = S / 64; }
  const int nt = kt1 - kt0;
  constexpr int KSTRG = MODE == 0 ? 96 : 64, VSTRG = 64;
  u32x4 rkA[KCH], rvA[1], rkB[KCH], rvB[1];
  auto gload = [&](int kt, u32x4 (&rk)[KCH], u32x4 (&rv)[1]) {
    const u16* kb = Kg + (size_t)kt * (64 * KSTRG);
    const u16* vb = Vg + (size_t)kt * (64 * VSTRG);
#pragma unroll
    for (int i = 0; i < KCH; ++i) if (tid + NTHR * i < KCHUNKS) rk[i] = *(const u32x4*)(kb + tid * 8 + NTHR * 8 * i);
    rv[0] = *(const u32x4*)(vb + tid * 8);
  };
  auto lstore = [&](int st, const u32x4 (&rk)[KCH], const u32x4 (&rv)[1]) {
    char* Ks = stage0 + st * STAGE;
#pragma unroll
    for (int i = 0; i < KCH; ++i) { int c = tid + NTHR * i, row = c / KCPR, ch = c % KCPR; if (c < KCHUNKS) *(u32x4*)(Ks + row * KSTR + ch * 16) = rk[i]; }
    { int row = tid >> 3, ch = tid & 7; *(u32x4*)(Ks + KBYTES + row * VSTR + ch * 16) = rv[0]; }
  };
  const unsigned vlane = (unsigned)((4 * hh + ((lane & 15) >> 2)) * VSTR + 32 * ((lane >> 4) & 1) + 8 * (lane & 3));
  bf16x8 kaug, qaug;
  { u32x4 tk = {hh == 0 ? 0x3F803F80u : 0u, 0u, 0u, 0u}; kaug = __builtin_bit_cast(bf16x8, tk); qaug = __builtin_bit_cast(bf16x8, (u32x4){0u, 0u, 0u, 0u}); }
  f32x16 c0p;
  auto set_c0 = [&](float c0) {
    const unsigned hi = f2bf(c0); const unsigned lo = f2bf(c0 - bf2f((u16)hi));
    u32x4 tq = {hh == 0 ? (hi | (lo << 16)) : 0u, 0u, 0u, 0u}; qaug = __builtin_bit_cast(bf16x8, tq);
    { const f32x16 z16 = {0.f, 0.f, 0.f, 0.f, 0.f, 0.f, 0.f, 0.f, 0.f, 0.f, 0.f, 0.f, 0.f, 0.f, 0.f, 0.f}; c0p = MFMA(kaug, qaug, z16); }
  };
  int c0cls = -1;
  auto compute = [&](const int t, const int cur) {
    const int k0 = (kt0 + t) * 64;
    const char* Ks = stage0 + cur * STAGE;
    bool active = true;
    if (MODE == 2) active = (k0 + 63 >= q0w - 128) && (k0 <= q0w + 159);
    if (active) {
      const float* brow = brel + (k0 - q0w - l32 + 4 * hh + 224);
      int cls = 0; float cb = 0.f;
      if (MODE == 1) {
        const int rmax = k0 + 63 - q0w, rmin = k0 - (q0w + 31);
        if (rmax <= -128) { cls = 1; cb = brel[224 - 128]; }
        else if (rmin >= 128) { cls = 2; cb = brel[224 + 128]; }
      }
      const bool far = cls != 0;
      if (cls != c0cls) { c0cls = cls; set_c0(cb - m); }
      const unsigned vaddr = (unsigned)(uintptr_t)(Ks + KBYTES) + vlane;
      typedef __attribute__((address_space(3))) s16x4 lds_s16x4;
      s16x4 vpre[16];
      u32x4 pk[NMAP][2][2];
#pragma unroll
      for (int mp = 0; mp < NMAP; ++mp) {
        f32x16 s[2];
        const f32x16 zero16 = {0.f, 0.f, 0.f, 0.f, 0.f, 0.f, 0.f, 0.f, 0.f, 0.f, 0.f, 0.f, 0.f, 0.f, 0.f, 0.f};
        __builtin_amdgcn_s_setprio(1);
        f32x16 c0tile;
        c0tile = c0p;
#pragma unroll
        for (int sub = 0; sub < 2; ++sub) {
#pragma unroll
          for (int st = 0; st < QS; ++st) {
            bf16x8 kf = *(const bf16x8*)(Ks + (32 * sub + l32) * KSTR + ((mp * QS + st) * 16 + hh * 8) * 2);
            if (st == 0) s[sub] = MFMA(kf, qf[mp][st], c0tile); else s[sub] = MFMA(kf, qf[mp][st], s[sub]);
          }
        }
        __builtin_amdgcn_iglp_opt(1);
        __builtin_amdgcn_s_setprio(0);
        if (NMAP == 1) {
          lds_s16x4* vb = (lds_s16x4*)(Ks + KBYTES + vlane);
#pragma unroll
          for (int i = 0; i < 16; ++i) {
            const int sub_ = i >> 3, ks_ = (i >> 2) & 1, dt_ = (i >> 1) & 1, g_ = i & 1;
            vpre[i] = __builtin_amdgcn_ds_read_tr16_b64_v4i16(vb + ((32 * sub_ + 16 * ks_ + 8 * g_) * VSTR + 64 * dt_) / 8);
          }
          __builtin_amdgcn_sched_barrier(0);
        }
        if (MODE != 0 && !far) {
#pragma unroll
          for (int sub = 0; sub < 2; ++sub)
#pragma unroll
            for (int r = 0; r < 16; ++r) s[sub][r] += brow[32 * sub + (r & 3) + 8 * (r >> 2)];
        }
        const bool first = (MODE != 2) && (t == 0) && (mp == 0);
        auto rebase = [&]() {
          float mx = fmaxf(fmaxf(s[0][0], s[0][1]), s[0][2]);
#pragma unroll
          for (int r = 3; r < 15; r += 2) mx = fmaxf(fmaxf(mx, s[0][r]), s[0][r + 1]);
          mx = fmaxf(mx, s[0][15]);
#pragma unroll
          for (int r = 0; r < 16; r += 2) mx = fmaxf(fmaxf(mx, s[1][r]), s[1][r + 1]);
          const float rm = xchg_max(mx);
          float delta = first ? rm : fmaxf(rm, 0.f);
          if (delta < -1e29f) delta = 0.f;
          m += delta;
          const float alpha = __builtin_amdgcn_exp2f(-delta);
#pragma unroll
          for (int mq = 0; mq < NMAP; ++mq) {
            l[mq] *= alpha;
#pragma unroll
            for (int r = 0; r < 16; ++r) { O[mq][0][r] *= alpha; O[mq][1][r] *= alpha; }
          }
#pragma unroll
          for (int r = 0; r < 16; ++r) { s[0][r] -= delta; s[1][r] -= delta; }
          set_c0(cb - m);
        };
        float ps;
        auto smpass = [&]() {
          ps = 0.f;
#pragma unroll
          for (int sub = 0; sub < 2; ++sub)
#pragma unroll
            for (int ks = 0; ks < 2; ++ks)
#pragma unroll
              for (int i = 0; i < 4; ++i) {
                const float p0 = __builtin_amdgcn_exp2f(s[sub][8 * ks + 2 * i]), p1 = __builtin_amdgcn_exp2f(s[sub][8 * ks + 2 * i + 1]);
                ps += p0 + p1; pk[mp][sub][ks][i] = pk2(p0, p1);
              }
        };
        if (first) rebase();
        smpass();
        if (!first && __any(!(ps <= PSLIM))) { rebase(); smpass(); }
        l[mp] += ps;
        __builtin_amdgcn_sched_barrier(0);
      }
#pragma unroll
      for (int sub = 0; sub < 2; ++sub) {
        s16x4 vv[8];
        if (NMAP == 1) {
#pragma unroll
          for (int i = 0; i < 8; ++i) vv[i] = vpre[sub * 8 + i];
        } else {
          if (sub == 0) trread8<0>(vaddr, vv); else trread8<32 * VSTR>(vaddr, vv);
        }
        __builtin_amdgcn_s_setprio(1);
#pragma unroll
        for (int ks = 0; ks < 2; ++ks) {
#pragma unroll
          for (int dt = 0; dt < 2; ++dt) {
            s16x4 lo = vv[ks * 4 + dt * 2], hi = vv[ks * 4 + dt * 2 + 1];
            bf16x8 vf = __builtin_shufflevector(lo, hi, 0, 1, 2, 3, 4, 5, 6, 7);
#pragma unroll
            for (int mp = 0; mp < NMAP; ++mp) O[mp][dt] = MFMA(vf, __builtin_bit_cast(bf16x8, pk[mp][sub][ks]), O[mp][dt]);
          }
        }
        __builtin_amdgcn_s_setprio(0);
        __builtin_amdgcn_sched_barrier(0);
      }
    }
  };
  __syncthreads();
  gload(kt0, rkA, rvA); lstore(0, rkA, rvA);
  if (nt > 1) gload(kt0 + 1, rkB, rvB);
  LDS_BARRIER();
  for (int t = 0; t < nt; t += 2) {
    if (t + 2 < nt) gload(kt0 + t + 2, rkA, rvA);
    compute(t, 0);
    if (t + 1 < nt) lstore(1, rkB, rvB);
    LDS_BARRIER();
    if (t + 1 >= nt) break;
    if (t + 3 < nt) gload(kt0 + t + 3, rkB, rvB);
    compute(t + 1, 1);
    if (t + 2 < nt) lstore(0, rkA, rvA);
    LDS_BARRIER();
  }
  __syncthreads();
  const size_t trow = (size_t)b * S + q0w + l32;
  const u16* grow = (const u16*)(p.ws + OFF_H) + trow * DIN + C_GATE + ocol;
  u16* orow = (u16*)(p.ws + OFF_OB) + trow * DM + ocol;
  float inv0 = 1.f / xchg_sum(l[0]);
  if (MODE == 1) {
    const float* lm = (const float*)(p.ws + OFF_LAM);
    const float lam = lm[layer], post = lm[4 + layer];
    const float inv1 = lam / xchg_sum(l[1]);
    float ss = 0.f;
#pragma unroll
    for (int dt = 0; dt < 2; ++dt)
#pragma unroll
      for (int r = 0; r < 16; ++r) { float v = O[0][dt][r] * inv0 - O[NMAP - 1][dt][r] * inv1; O[0][dt][r] = v; ss += v * v; }
    ss = xchg_sum(ss);
    inv0 = rsqrtf(ss * (1.f / 64.f) + 1e-6f) * post;
  }
#pragma unroll
  for (int dt = 0; dt < 2; ++dt)
#pragma unroll
    for (int g = 0; g < 4; ++g) {
      const int d = 32 * dt + 8 * g + 4 * hh;
      u32x2 gw = *(const u32x2*)(grow + d);
      float v0 = O[0][dt][4 * g + 0] * inv0, v1 = O[0][dt][4 * g + 1] * inv0, v2 = O[0][dt][4 * g + 2] * inv0, v3 = O[0][dt][4 * g + 3] * inv0;
      if (MODE == 1) { const float* sl = p.subln + layer * 64 + d; v0 *= sl[0]; v1 *= sl[1]; v2 *= sl[2]; v3 *= sl[3]; }
      v0 *= bflo(gw[0]); v1 *= bfhi(gw[0]); v2 *= bflo(gw[1]); v3 *= bfhi(gw[1]);
      u32x2 ow = {pk2(v0, v1), pk2(v2, v3)};
#ifdef PROBE_ZERO_MODE
      if (MODE == PROBE_ZERO_MODE) { ow[0] = 0u; ow[1] = 0u; }
#endif
      *(u32x2*)(orow + d) = ow;
    }
}

DI void phase_attn(const Params& p, int layer, char* lds) {
  constexpr int N_MLA = 24 * 32, N_DIFF = 16 * 32, N_SWA = 24 * 32;
  for (int g = blockIdx.x; g < N_MLA + N_DIFF + N_SWA; g += gridDim.x) {
    if (g < N_MLA) { int i = g; attn_item<0>(p, layer, (i & 7) + 8 * (i >> 8), (i >> 3) & 31, lds); }
    else if (g < N_MLA + N_DIFF) { int i = g - N_MLA; attn_item<1>(p, layer, (i & 7) + 8 * (i >> 8), (i >> 3) & 31, lds); }
    else { int i = g - N_MLA - N_DIFF; attn_item<2>(p, layer, (i & 7) + 8 * (i >> 8), (i >> 3) & 31, lds); }
  }
}

DI void phase_outproj(const Params& p, int layer, char* lds) {
  const u16* ob = (const u16*)(p.ws + OFF_OB);
  const u16* wt = (const u16*)(p.ws + OFF_WOUT) + (size_t)layer * DM * DM;
  const float* xres = layer == 0 ? p.x : p.out;
  float* xout = p.out;
  int tid_ = threadIdx.x; asm volatile("" : "+v"(tid_)); const int tid = tid_, lane = tid & 63, w = tid >> 6, l32 = lane & 31, hh = lane >> 5, wm = w & 1, wn = w >> 1;
  constexpr int NTN = DM / 256, NRB = T / 256, NTILES = NRB * NTN;
  const bool xcd_ok = (gridDim.x % 8) == 0;
  const int xj = xcd_ok ? (int)(blockIdx.x & 7) : 0, nbl = xcd_ok ? (int)(gridDim.x >> 3) : (int)gridDim.x;
  const int bl = xcd_ok ? (int)(blockIdx.x >> 3) : (int)blockIdx.x, per_x = xcd_ok ? NTILES / 8 : NTILES;
  for (int u = bl; u < per_x; u += nbl) {
    const int lr = u / NTN, nt = u % NTN, mt = xcd_ok ? lr * 8 + xj : lr, m0 = mt * 256, n0 = nt * 256;
    const int wr8 = w >> 2, wc8 = w & 3, fr = lane & 15, fq = lane >> 4;
    const size_t base = (size_t)(m0 + wr8 * 64 + fq * 4) * DM + (n0 + wc8 * 32 + fr);
    f32x4 acc[2][2][4][2];
#pragma unroll
    for (int ai = 0; ai < 2; ++ai)
#pragma unroll
      for (int bj = 0; bj < 2; ++bj)
#pragma unroll
        for (int m = 0; m < 4; ++m)
#pragma unroll
          for (int n = 0; n < 2; ++n) acc[ai][bj][m][n] = (f32x4){0.f, 0.f, 0.f, 0.f};
    gemm8p(ob, wt, m0, n0, acc);
    u16* yo = (u16*)(p.ws + OFF_XB) + base;
#pragma unroll
    for (int ai = 0; ai < 2; ++ai)
#pragma unroll
      for (int bj = 0; bj < 2; ++bj)
#pragma unroll
        for (int m = 0; m < 4; ++m) {
#pragma unroll
          for (int n = 0; n < 2; ++n)
#pragma unroll
            for (int j = 0; j < 4; ++j) yo[(ai * 128 + m * 16 + j) * DM + bj * 128 + n * 16] = f2bf(acc[ai][bj][m][n][j]);
          __builtin_amdgcn_sched_barrier(0);
        }
  }
}

DI void phase_ln(const Params& p, int layer) {
  const float* xres = layer == 0 ? p.x : p.out;
  float* xout = p.out;
  u16* xb = (u16*)(p.ws + OFF_XB);
  const float* lg = p.ln_g + layer * DM; const float* lb = p.ln_b + layer * DM;
  int tid_ = threadIdx.x; asm volatile("" : "+v"(tid_)); const int tid = tid_, lane = tid & 63, w = tid >> 6;
#pragma unroll 1
  for (size_t row = (size_t)blockIdx.x * 8 + w; row < (size_t)T; row += (size_t)gridDim.x * 8) {
    f32x4 v[4]; float sum = 0.f;
#pragma unroll
    for (int i = 0; i < 4; ++i) {
      const f32x4 xv = *(const f32x4*)(xres + row * DM + 4 * lane + 256 * i);
      const u32x2 yw = *(const u32x2*)(xb + row * DM + 4 * lane + 256 * i);
      v[i][0] = ALPHA * xv[0] + bflo(yw[0]); v[i][1] = ALPHA * xv[1] + bfhi(yw[0]); v[i][2] = ALPHA * xv[2] + bflo(yw[1]); v[i][3] = ALPHA * xv[3] + bfhi(yw[1]);
      sum += v[i][0] + v[i][1] + v[i][2] + v[i][3];
    }
    const float mu = wave_sum(sum) * (1.f / DM);
    float sq = 0.f;
#pragma unroll
    for (int i = 0; i < 4; ++i)
#pragma unroll
      for (int j = 0; j < 4; ++j) { float d = v[i][j] - mu; sq += d * d; }
    const float rstd = rsqrtf(wave_sum(sq) * (1.f / DM) + 1e-5f);
#pragma unroll
    for (int i = 0; i < 4; ++i) {
      const int col = 4 * lane + 256 * i;
      f32x4 g = *(const f32x4*)(lg + col), bb = *(const f32x4*)(lb + col), o;
#pragma unroll
      for (int j = 0; j < 4; ++j) o[j] = (v[i][j] - mu) * rstd * g[j] + bb[j];
      *(f32x4*)(xout + row * DM + col) = o;
      if (layer + 1 < DEPTH) {
        u32x2 ow = {pk2(o[0], o[1]), pk2(o[2], o[3])};
        *(u32x2*)(xb + row * DM + col) = ow;
      }
    }
  }
}

#if MK_COOP
DI void fast_grid_sync(unsigned* ctr, unsigned& epoch) {
  asm volatile("s_waitcnt vmcnt(0) lgkmcnt(0)" ::: "memory");
  __syncthreads();
  epoch += 1u;
  if (threadIdx.x == 0) {
    __builtin_amdgcn_fence(__ATOMIC_RELEASE, "agent");
    asm volatile("s_waitcnt vmcnt(0)" ::: "memory");
    const unsigned target = epoch * gridDim.x;
    (void)__hip_atomic_fetch_add(ctr, 1u, __ATOMIC_RELAXED, __HIP_MEMORY_SCOPE_AGENT);
    unsigned spins = 0;
    while (__hip_atomic_load(ctr, __ATOMIC_RELAXED, __HIP_MEMORY_SCOPE_AGENT) < target) {
      __builtin_amdgcn_s_sleep(2);
      if (++spins > (1u << 26)) break;
    }
    __builtin_amdgcn_fence(__ATOMIC_ACQUIRE, "agent");
    asm volatile("s_waitcnt vmcnt(0)" ::: "memory");
  }
  __syncthreads();
}

__global__ void __launch_bounds__(NTHR) fwd_megakernel(Params p) {
  char* lds = lds_dyn;
  cg::grid_group grid = cg::this_grid();
  unsigned* bar_ctr = (unsigned*)(p.ws + OFF_BAR); unsigned bar_epoch = 0;
  phase_prep(p, lds);
  grid.sync();
  for (int layer = 0; layer < DEPTH; ++layer) {
    phase_inproj(p, layer, lds);
    fast_grid_sync(bar_ctr, bar_epoch);
    phase_mla_up(p, layer, lds);
    fast_grid_sync(bar_ctr, bar_epoch);
#ifdef PROBE_REP_P12
    phase_inproj(p, layer, lds);
    fast_grid_sync(bar_ctr, bar_epoch);
    phase_mla_up(p, layer, lds);
    fast_grid_sync(bar_ctr, bar_epoch);
#endif
#ifdef PROBE_REP_P2
    phase_mla_up(p, layer, lds);
    fast_grid_sync(bar_ctr, bar_epoch);
#endif
    phase_attn(p, layer, lds);
#ifdef PROBE_REP_ATTN
    fast_grid_sync(bar_ctr, bar_epoch);
    phase_attn(p, layer, lds);
#endif
    fast_grid_sync(bar_ctr, bar_epoch);
    phase_outproj(p, layer, lds);
    fast_grid_sync(bar_ctr, bar_epoch);
    phase_ln(p, layer);
    if (layer + 1 < DEPTH) fast_grid_sync(bar_ctr, bar_epoch);
  }
}
#else
template <int PH>
__global__ void __launch_bounds__(NTHR, 2) phase_kernel(Params p, int layer) {
  __shared__ __attribute__((aligned(16))) char lds[LDS_BYTES];
  if (PH == 0) phase_prep(p, lds);
  if (PH == 1) phase_inproj(p, layer, lds);
  if (PH == 2) phase_mla_up(p, layer, lds);
  if (PH == 3) phase_attn(p, layer, lds);
  if (PH == 4) phase_outproj(p, layer, lds);
  if (PH == 5) phase_ln(p, layer);
}
#endif

extern "C" void kernel_launch(void* const* d_in, const int* in_sizes, int n_in, void* d_out, int out_size, void* d_ws, size_t ws_size,
                              hipStream_t stream) {
  if (n_in != 13 || ws_size < WS_END || out_size != T * DM) {
    fprintf(stderr, "kernel_launch: unexpected shapes n_in %d ws %zu (need %zu) out %d\n", n_in, ws_size, WS_END, out_size);
    return;
  }
  Params p{};
  p.x = (const float*)d_in[0]; p.w_in = (const float*)d_in[1]; p.qn = (const float*)d_in[2]; p.kvn = (const float*)d_in[3];
  p.w_uq = (const float*)d_in[4]; p.w_ukv = (const float*)d_in[5]; p.lamv = (const float*)d_in[6]; p.subln = (const float*)d_in[7];
  p.sink = (const float*)d_in[8]; p.relb = (const float*)d_in[9]; p.w_out = (const float*)d_in[10]; p.ln_g = (const float*)d_in[11];
  p.ln_b = (const float*)d_in[12]; p.out = (float*)d_out; p.ws = (char*)d_ws;
#if MK_COOP
  static int grid_blocks = 0;
  if (!grid_blocks) {
    int dev = 0, cus = 0, per_cu = 0;
    hipGetDevice(&dev);
    hipDeviceGetAttribute(&cus, hipDeviceAttributeMultiprocessorCount, dev);
    if (hipFuncSetAttribute((const void*)fwd_megakernel, hipFuncAttributeMaxDynamicSharedMemorySize, LDS_BYTES) != hipSuccess)
      fprintf(stderr, "kernel_launch: hipFuncSetAttribute(%d B dynamic LDS) failed\n", LDS_BYTES);
    hipOccupancyMaxActiveBlocksPerMultiprocessor(&per_cu, fwd_megakernel, NTHR, LDS_BYTES);
    (void)hipGetLastError();
    (void)per_cu;
    grid_blocks = cus;
  }
  (void)hipMemsetAsync((char*)d_ws + OFF_BAR, 0, 256, stream);
  void* args[] = {&p};
  hipError_t e = hipLaunchCooperativeKernel((void*)fwd_megakernel, dim3(grid_blocks), dim3(NTHR), args, LDS_BYTES, stream);
  if (e != hipSuccess) fprintf(stderr, "cooperative launch failed: %s (grid %d)\n", hipGetErrorString(e), grid_blocks);
#else
  const int G = 512;
  hipLaunchKernelGGL(phase_kernel<0>, dim3(G), dim3(NTHR), 0, stream, p, 0);
  for (int l = 0; l < DEPTH; ++l) {
    hipLaunchKernelGGL(phase_kernel<1>, dim3(G), dim3(NTHR), 0, stream, p, l);
    hipLaunchKernelGGL(phase_kernel<2>, dim3(G), dim3(NTHR), 0, stream, p, l);
    hipLaunchKernelGGL(phase_kernel<3>, dim3(G), dim3(NTHR), 0, stream, p, l);
    hipLaunchKernelGGL(phase_kernel<4>, dim3(G), dim3(NTHR), 0, stream, p, l);
    hipLaunchKernelGGL(phase_kernel<5>, dim3(G), dim3(NTHR), 0, stream, p, l);
  }
#endif
}
```

```cpp
#include <hip/hip_runtime.h>
#include <hip/hip_cooperative_groups.h>
#include <cstdio>
#include <cstdint>
namespace cg = cooperative_groups;

#ifndef MK_COOP
#define MK_COOP 1
#endif

#define DI __device__ __forceinline__
typedef unsigned short u16;
using bf16x8 = __attribute__((ext_vector_type(8))) short;
using s16x4  = __attribute__((ext_vector_type(4))) short;
using f32x16 = __attribute__((ext_vector_type(16))) float;
using f32x4  = __attribute__((ext_vector_type(4))) float;
using f32x2  = __attribute__((ext_vector_type(2))) float;
using u32x4  = __attribute__((ext_vector_type(4))) unsigned;
using u32x2  = __attribute__((ext_vector_type(2))) unsigned;
using b16x2  = __attribute__((ext_vector_type(2))) __bf16;
#define MFMA(a, b, c) __builtin_amdgcn_mfma_f32_32x32x16_bf16((a), (b), (c), 0, 0, 0)

constexpr int NB = 4, S = 8192, T = NB * S, DM = 1024, DIN = 2784, DEPTH = 4;
constexpr int C_CQ = 0, C_CKV = 192, C_KR = 320, C_DQ = 352, C_DK = 608, C_DV = 864, C_SQ = 1120, C_SK = 1504, C_SV = 1632, C_GATE = 1760;
constexpr int QW = 576, KW = 576, VW = 384;
constexpr float LOG2E = 1.4426950408889634f;
constexpr float ALPHA = 1.681792830507429f;
constexpr int NTHR = 512;
constexpr float PSLIM = 4096.0f;

constexpr size_t SZ_WIN = (size_t)DEPTH * DIN * DM * 2, SZ_WOUT = (size_t)DEPTH * DM * DM * 2;
constexpr size_t SZ_WUQ = (size_t)DEPTH * 576 * 192 * 2, SZ_WUKV = (size_t)DEPTH * 768 * 128 * 2;
constexpr size_t SZ_ROPE = (size_t)S * 16 * 8, SZ_LAM = 256;
constexpr size_t SZ_XB = (size_t)T * DM * 2, SZ_H = (size_t)T * DIN * 2, SZ_QB = (size_t)T * QW * 2, SZ_KB = (size_t)T * KW * 2;
constexpr size_t SZ_VB = (size_t)T * VW * 2, SZ_OB = (size_t)T * DM * 2, SZ_DK = (size_t)T * 256 * 2, SZ_SK = (size_t)T * 128 * 2;
constexpr size_t OFF_WIN = 0, OFF_WOUT = OFF_WIN + SZ_WIN, OFF_WUQ = OFF_WOUT + SZ_WOUT, OFF_WUKV = OFF_WUQ + SZ_WUQ;
constexpr size_t OFF_ROPE = OFF_WUKV + SZ_WUKV, OFF_LAM = OFF_ROPE + SZ_ROPE, OFF_XB = OFF_LAM + SZ_LAM, OFF_H = OFF_XB + SZ_XB;
constexpr size_t OFF_QB = OFF_H + SZ_H, OFF_KB = OFF_QB + SZ_QB, OFF_VB = OFF_KB + SZ_KB, OFF_OB = OFF_VB + SZ_VB, OFF_DK = OFF_OB + SZ_OB, OFF_DV = OFF_DK + SZ_DK, OFF_SK = OFF_DV + SZ_DK, OFF_SV = OFF_SK + SZ_SK, OFF_BAR = OFF_SV + SZ_SK, WS_END = OFF_BAR + 256;

struct Params {
  const float *x, *w_in, *qn, *kvn, *w_uq, *w_ukv, *lamv, *subln, *sink, *relb, *w_out, *ln_g, *ln_b;
  float* out;
  char* ws;
};

extern __shared__ __attribute__((aligned(16))) char lds_dyn[];
constexpr int LDS_BYTES = 147456;

DI u16 f2bf(float x) { unsigned u = __float_as_uint(x); u += 0x7fffu + ((u >> 16) & 1u); return (u16)(u >> 16); }
DI float bf2f(u16 b) { return __uint_as_float(((unsigned)b) << 16); }
DI unsigned pk2(float lo, float hi) { f32x2 v = {lo, hi}; b16x2 r = __builtin_convertvector(v, b16x2); return __builtin_bit_cast(unsigned, r); }
DI float bflo(unsigned w) { return __uint_as_float(w << 16); }
DI float bfhi(unsigned w) { return __uint_as_float(w & 0xffff0000u); }
DI int crow(int r, int hh) { return (r & 3) + 8 * (r >> 2) + 4 * hh; }
DI float xchg_max(float v) {
  auto rr = __builtin_amdgcn_permlane32_swap(__float_as_uint(v), __float_as_uint(v), false, false);
  return fmaxf(__uint_as_float(rr[0]), __uint_as_float(rr[1]));
}
DI float xchg_sum(float v) {
  auto rr = __builtin_amdgcn_permlane32_swap(__float_as_uint(v), __float_as_uint(v), false, false);
  return __uint_as_float(rr[0]) + __uint_as_float(rr[1]);
}
DI float wave_sum(float v) {
  for (int o = 32; o >= 1; o >>= 1) v += __shfl_xor(v, o);
  return v;
}
DI int t5_bucket(int rel) {
  int n = rel < 0 ? -rel : rel;
  int b;
  if (n < 8) b = n;
  else b = 8 + (n >= 12) + (n >= 16) + (n >= 23) + (n >= 32) + (n >= 46) + (n >= 64) + (n >= 91);
  return b + (rel > 0 ? 16 : 0);
}
DI bf16x8 pack8(const f32x16& x, int s8) {
  u32x4 p = {pk2(x[s8 + 0], x[s8 + 1]), pk2(x[s8 + 2], x[s8 + 3]), pk2(x[s8 + 4], x[s8 + 5]), pk2(x[s8 + 6], x[s8 + 7])};
  return __builtin_bit_cast(bf16x8, p);
}

__device__ __constant__ float ROPE_FREQ[16] = {
  1.0f, 0.5623413324356079f, 0.3162277638912201f, 0.17782793939113617f, 0.10000000149011612f, 0.05623413249850273f,
  0.03162277489900589f, 0.017782794311642647f, 0.009999999776482582f, 0.005623413249850273f, 0.003162277629598975f,
  0.0017782794311642647f, 0.0010000000474974513f, 0.000562341301701963f, 0.0003162277571391314f, 0.00017782794020604342f};

DI void prep_transpose_tile(const float* __restrict__ src, u16* __restrict__ dst, int R, int C, const float* __restrict__ g, int tr, int tc, float* lds) {
  int tid_ = threadIdx.x; asm volatile("" : "+v"(tid_)); const int tid = tid_;
  for (int i = tid; i < 4096; i += NTHR) {
    int r = i >> 6, c = i & 63, gr = tr * 64 + r, gc = tc * 64 + c;
    float v = 0.f;
    if (gr < R && gc < C) { v = src[(size_t)gr * C + gc]; if (g) v *= g[gr]; }
    lds[r * 65 + c] = v;
  }
  __syncthreads();
  for (int i = tid; i < 4096; i += NTHR) {
    int c = i >> 6, r = i & 63, gr = tr * 64 + r, gc = tc * 64 + c;
    if (gr < R && gc < C) dst[(size_t)gc * R + gr] = f2bf(lds[r * 65 + c]);
  }
  __syncthreads();
}

DI void sincos_d(double a, float& c, float& s) {
  const double TWO_PI = 6.283185307179586476925286766559, INV_TWO_PI = 0.15915494309189533576888376337251;
  double n = rint(a * INV_TWO_PI);
  double r = fma(-n, TWO_PI, a);
  r = fma(-n, 2.4492935982947064e-16, r);
  double r2 = r * r;
  double sp = 1.0 / 15511210043330985984000000.0;
  sp = fma(sp, r2, -1.0 / 25852016738884976640000.0);
  sp = fma(sp, r2, 1.0 / 51090942171709440000.0);
  sp = fma(sp, r2, -1.0 / 121645100408832000.0);
  sp = fma(sp, r2, 1.0 / 355687428096000.0);
  sp = fma(sp, r2, -1.0 / 1307674368000.0);
  sp = fma(sp, r2, 1.0 / 6227020800.0);
  sp = fma(sp, r2, -1.0 / 39916800.0);
  sp = fma(sp, r2, 1.0 / 362880.0);
  sp = fma(sp, r2, -1.0 / 5040.0);
  sp = fma(sp, r2, 1.0 / 120.0);
  sp = fma(sp, r2, -1.0 / 6.0);
  sp = fma(sp, r2, 1.0);
  double cp = 1.0 / 620448401733239439360000.0;
  cp = fma(cp, r2, -1.0 / 1124000727777607680000.0);
  cp = fma(cp, r2, 1.0 / 2432902008176640000.0);
  cp = fma(cp, r2, -1.0 / 6402373705728000.0);
  cp = fma(cp, r2, 1.0 / 20922789888000.0);
  cp = fma(cp, r2, -1.0 / 87178291200.0);
  cp = fma(cp, r2, 1.0 / 479001600.0);
  cp = fma(cp, r2, -1.0 / 3628800.0);
  cp = fma(cp, r2, 1.0 / 40320.0);
  cp = fma(cp, r2, -1.0 / 720.0);
  cp = fma(cp, r2, 1.0 / 24.0);
  cp = fma(cp, r2, -0.5);
  cp = fma(cp, r2, 1.0);
  s = (float)(sp * r); c = (float)cp;
}

DI void phase_prep(const Params& p, char* lds) {
  u16* wt_in = (u16*)(p.ws + OFF_WIN); u16* wt_out = (u16*)(p.ws + OFF_WOUT);
  u16* wt_uq = (u16*)(p.ws + OFF_WUQ); u16* wt_ukv = (u16*)(p.ws + OFF_WUKV);
  constexpr int N_IN = 16 * 44, N_OUT = 16 * 16, N_UQ = 3 * 9, N_UKV = 2 * 12;
  constexpr int PER_L = N_IN + N_OUT + N_UQ + N_UKV;
  for (int it = blockIdx.x; it < DEPTH * PER_L; it += gridDim.x) {
    int l = it / PER_L, j = it % PER_L;
    if (j < N_IN) prep_transpose_tile(p.w_in + (size_t)l * DM * DIN, wt_in + (size_t)l * DIN * DM, DM, DIN, nullptr, j / 44, j % 44, (float*)lds);
    else if ((j -= N_IN) < N_OUT) prep_transpose_tile(p.w_out + (size_t)l * DM * DM, wt_out + (size_t)l * DM * DM, DM, DM, nullptr, j / 16, j % 16, (float*)lds);
    else if ((j -= N_OUT) < N_UQ) prep_transpose_tile(p.w_uq + (size_t)l * 192 * 576, wt_uq + (size_t)l * 576 * 192, 192, 576, p.qn + l * 192, j / 9, j % 9, (float*)lds);
    else { j -= N_UQ; prep_transpose_tile(p.w_ukv + (size_t)l * 128 * 768, wt_ukv + (size_t)l * 768 * 128, 128, 768, p.kvn + l * 128, j / 12, j % 12, (float*)lds); }
  }
  const size_t gtid = (size_t)blockIdx.x * NTHR + threadIdx.x, gsz = (size_t)gridDim.x * NTHR;
  u16* xb = (u16*)(p.ws + OFF_XB);
  for (size_t i = gtid; i < (size_t)T * DM / 8; i += gsz) {
    f32x4 a = *(const f32x4*)(p.x + i * 8), b = *(const f32x4*)(p.x + i * 8 + 4);
    u32x4 o = {pk2(a[0], a[1]), pk2(a[2], a[3]), pk2(b[0], b[1]), pk2(b[2], b[3])};
    *(u32x4*)(xb + i * 8) = o;
  }
  f32x2* rt = (f32x2*)(p.ws + OFF_ROPE);
  for (size_t i = gtid; i < (size_t)S * 16; i += gsz) {
    int pos = (int)(i >> 4), k = (int)(i & 15);
    float ang = (float)pos * ROPE_FREQ[k];
    float c, s; sincos_d((double)ang, c, s);
    f32x2 v = {c, s}; rt[i] = v;
  }
  if (blockIdx.x == 0 && threadIdx.x < DEPTH) {
    int l = threadIdx.x; const float* lv = p.lamv + l * 128;
    float d1 = 0.f, d2 = 0.f;
    for (int i = 0; i < 32; ++i) { d1 += lv[i] * lv[32 + i]; d2 += lv[64 + i] * lv[96 + i]; }
    float lam_init = 0.8f - 0.6f * expf(-0.3f * (float)l);
    float* lm = (float*)(p.ws + OFF_LAM);
    lm[l] = expf(d1) - expf(d2) + lam_init;
    lm[4 + l] = 1.0f - lam_init;
  }
}

#define LDS_BARRIER() asm volatile("s_waitcnt lgkmcnt(0)\n\ts_barrier" ::: "memory")
DI void gemm256(const u16* __restrict__ A, int lda, const u16* __restrict__ Bt, int ldb, int m0, int n0, int nvalid, int K,
                char* lds, f32x16 (&acc)[4][2], const float* cinit = nullptr) {
  constexpr int ASZ = 256 * 144, STG = 2 * ASZ;
  int tid_ = threadIdx.x; asm volatile("" : "+v"(tid_)); const int tid = tid_, lane = tid & 63, w = tid >> 6, l32 = lane & 31, hh = lane >> 5, wm = w & 1, wn = w >> 1;
  if (cinit) {
    const float* cp = cinit + (size_t)(m0 + 128 * wm + 4 * hh) * DM + (n0 + 64 * wn + l32);
#pragma unroll
    for (int mi = 0; mi < 4; ++mi)
#pragma unroll
      for (int ni = 0; ni < 2; ++ni)
#pragma unroll
        for (int r = 0; r < 16; ++r) acc[mi][ni][r] = ALPHA * cp[(32 * mi + (r & 3) + 8 * (r >> 2)) * DM + 32 * ni];
  } else {
#pragma unroll
    for (int mi = 0; mi < 4; ++mi)
#pragma unroll
      for (int ni = 0; ni < 2; ++ni)
#pragma unroll
        for (int r = 0; r < 16; ++r) acc[mi][ni][r] = 0.f;
  }
  u32x4 ra[4], rb[4];
  const int KT = K / 64;
  const int lrow = tid >> 3, lch = tid & 7;
  const u16* ap = A + (size_t)(m0 + lrow) * lda + lch * 8;
  const u16* bp = Bt + (size_t)(n0 + lrow) * ldb + lch * 8;
  auto gload = [&](int kt) {
#pragma unroll
    for (int i = 0; i < 4; ++i) ra[i] = *(const u32x4*)(ap + (size_t)(64 * i) * lda + kt * 64);
#pragma unroll
    for (int i = 0; i < 4; ++i) { u32x4 z = {0u, 0u, 0u, 0u};
      rb[i] = (lrow + 64 * i < nvalid) ? *(const u32x4*)(bp + (size_t)(64 * i) * ldb + kt * 64) : z; }
  };
  auto lstore = [&](int st) {
    char* As = lds + st * STG + lrow * 144 + lch * 16;
#pragma unroll
    for (int i = 0; i < 4; ++i) *(u32x4*)(As + 64 * i * 144) = ra[i];
#pragma unroll
    for (int i = 0; i < 4; ++i) *(u32x4*)(As + ASZ + 64 * i * 144) = rb[i];
  };
  auto compute = [&](int st) {
    const char* As = lds + st * STG + (128 * wm + l32) * 144 + hh * 16;
    const char* Bs = lds + st * STG + ASZ + (64 * wn + l32) * 144 + hh * 16;
    bf16x8 a0[4], b0[2], a1[4], b1[2];
#define LDFRAG(K16, AF, BF) do { _Pragma("unroll") for (int mi = 0; mi < 4; ++mi) AF[mi] = *(const bf16x8*)(As + 32 * mi * 144 + (K16) * 32); \
    _Pragma("unroll") for (int ni = 0; ni < 2; ++ni) BF[ni] = *(const bf16x8*)(Bs + 32 * ni * 144 + (K16) * 32); } while (0)
#define MMSTEP(AF, BF) do { _Pragma("unroll") for (int mi = 0; mi < 4; ++mi) _Pragma("unroll") for (int ni = 0; ni < 2; ++ni) acc[mi][ni] = MFMA(AF[mi], BF[ni], acc[mi][ni]); } while (0)
#define SGB(mask, n) __builtin_amdgcn_sched_group_barrier(mask, n, 0)
#define PIPE_STEP() do { SGB(0x100, 1); SGB(0x008, 1); SGB(0x100, 1); SGB(0x008, 1); SGB(0x100, 1); SGB(0x008, 1); SGB(0x100, 1); SGB(0x008, 1); \
    SGB(0x100, 1); SGB(0x008, 1); SGB(0x100, 1); SGB(0x008, 1); SGB(0x008, 2); } while (0)
    LDFRAG(0, a0, b0);
    LDFRAG(1, a1, b1); MMSTEP(a0, b0);
    LDFRAG(2, a0, b0); MMSTEP(a1, b1);
    LDFRAG(3, a1, b1); MMSTEP(a0, b0);
    MMSTEP(a1, b1);
    __builtin_amdgcn_iglp_opt(1);
#undef LDFRAG
#undef MMSTEP
#undef PIPE_STEP
  };
  gload(0); lstore(0);
  LDS_BARRIER();
  for (int kt = 0; kt < KT; ++kt) {
    if (kt + 1 < KT) gload(kt + 1);
    compute(kt & 1);
    if (kt + 1 < KT) lstore((kt + 1) & 1);
    LDS_BARRIER();
  }
}

DI int g8_lds_byte(int r, int c) { int st = (r >> 4) * 2 + (c >> 5), rr = r & 15, cc = c & 31, ob = rr * 64 + cc * 2; return st * 1024 + (ob ^ (((ob >> 9) & 1) << 5)); }
DI void g8_stage_rc(int b, int& R, int& C) { int st = b / 1024, sb = b % 1024, swz = sb ^ (((sb >> 9) & 1) << 5); R = (st >> 1) * 16 + swz / 64; C = (st & 1) * 32 + (swz % 64) / 2; }
DI void gemm8p(const u16* __restrict__ A, const u16* __restrict__ Bt, int brow, int bcol, f32x4 (&acc)[2][2][4][2]) {
  constexpr int K = 1024, BK = 64, HALF = 128, HT = HALF * BK;
  u16* shm = (u16*)lds_dyn;
#define G8_SA(b, h) (shm + ((b) * 2 + (h)) * HT)
#define G8_SB(b, h) (shm + (4 + (b) * 2 + (h)) * HT)
#define G8_STAGE(P, BASE, br, kt) do { const u16* gb_ = (BASE) + ((long)(br) * K + (long)(kt) * BK);     \
      __builtin_amdgcn_global_load_lds((const unsigned*)(gb_ + soff0), (__attribute__((address_space(3))) unsigned*)((char*)(P) + tid8 * 16), 16, 0, 0); \
      __builtin_amdgcn_global_load_lds((const unsigned*)(gb_ + soff1), (__attribute__((address_space(3))) unsigned*)((char*)(P) + tid8 * 16 + 8192), 16, 0, 0); } while (0)
#define G8_LDA(dst, b, h) for (int m = 0; m < 4; ++m) for (int k = 0; k < 2; ++k) \
    dst[m][k] = *reinterpret_cast<const bf16x8*>((char*)G8_SA(b, h) + g8_lds_byte(wr * 64 + m * 16 + fr, k * 32 + fq * 8))
#define G8_LDB(dst, b, h) for (int n = 0; n < 2; ++n) for (int k = 0; k < 2; ++k) \
    dst[n][k] = *reinterpret_cast<const bf16x8*>((char*)G8_SB(b, h) + g8_lds_byte(wc * 32 + n * 16 + fr, k * 32 + fq * 8))
#define G8_MMA(ai, bj, At_, Bt_) do { __builtin_amdgcn_s_setprio(1); \
    for (int m = 0; m < 4; ++m) for (int n = 0; n < 2; ++n) for (int k = 0; k < 2; ++k) \
      acc[ai][bj][m][n] = __builtin_amdgcn_mfma_f32_16x16x32_bf16(At_[m][k], Bt_[n][k], acc[ai][bj][m][n], 0, 0, 0); \
    __builtin_amdgcn_s_setprio(0); } while (0)
#define G8_WV(n) asm volatile("s_waitcnt vmcnt(" #n ")" ::: "memory")
#define G8_WL(n) asm volatile("s_waitcnt lgkmcnt(" #n ")" ::: "memory")
#define G8_BAR __builtin_amdgcn_s_barrier()
#define G8_SCHED __builtin_amdgcn_sched_barrier(0)
  int tid8 = threadIdx.x; asm volatile("" : "+v"(tid8));
  const int wid = tid8 >> 6, lane = tid8 & 63, wr = wid >> 2, wc = wid & 3, fr = lane & 15, fq = lane >> 4;
  int soff0, soff1;
  { int r_, c_; g8_stage_rc(tid8 * 16, r_, c_); soff0 = r_ * K + c_; g8_stage_rc(tid8 * 16 + 8192, r_, c_); soff1 = r_ * K + c_; }
  bf16x8 At[4][2], B0[2][2], B1[2][2];
  constexpr int nt = K / BK;
  __syncthreads();
  G8_STAGE(G8_SB(0, 0), Bt, bcol, 0); G8_STAGE(G8_SA(0, 0), A, brow, 0);
  G8_STAGE(G8_SB(0, 1), Bt, bcol + HALF, 0); G8_STAGE(G8_SA(0, 1), A, brow + HALF, 0);
  if (wr == 1) G8_BAR;
  G8_WV(4); G8_BAR;
  G8_STAGE(G8_SB(1, 0), Bt, bcol, 1); G8_STAGE(G8_SA(1, 0), A, brow, 1); G8_STAGE(G8_SB(1, 1), Bt, bcol + HALF, 1);
  G8_WV(6); G8_BAR;
#pragma unroll 1
  for (int t = 0; t < nt - 2; t += 2) {
    G8_LDB(B0, 0, 0); G8_SCHED; G8_LDA(At, 0, 0); G8_STAGE(G8_SA(1, 1), A, brow + HALF, t + 1);
    G8_WL(8); G8_BAR; G8_WL(0); G8_MMA(0, 0, At, B0); G8_BAR; G8_SCHED;
    G8_LDB(B1, 0, 1); G8_STAGE(G8_SB(0, 0), Bt, bcol, t + 2);
    G8_BAR; G8_WL(0); G8_MMA(0, 1, At, B1); G8_BAR;
    G8_LDA(At, 0, 1); G8_STAGE(G8_SA(0, 0), A, brow, t + 2);
    G8_BAR; G8_WL(0); G8_MMA(1, 0, At, B0); G8_BAR; G8_SCHED;
    G8_STAGE(G8_SB(0, 1), Bt, bcol + HALF, t + 2);
    G8_WV(6); G8_BAR; G8_MMA(1, 1, At, B1); G8_BAR;
    G8_LDB(B0, 1, 0); G8_SCHED; G8_LDA(At, 1, 0); G8_STAGE(G8_SA(0, 1), A, brow + HALF, t + 2);
    G8_WL(8); G8_BAR; G8_WL(0); G8_MMA(0, 0, At, B0); G8_BAR; G8_SCHED;
    G8_LDB(B1, 1, 1); G8_STAGE(G8_SB(1, 0), Bt, bcol, t + 3);
    G8_BAR; G8_WL(0); G8_MMA(0, 1, At, B1); G8_BAR;
    G8_LDA(At, 1, 1); G8_STAGE(G8_SA(1, 0), A, brow, t + 3);
    G8_BAR; G8_WL(0); G8_MMA(1, 0, At, B0); G8_BAR; G8_SCHED;
    G8_STAGE(G8_SB(1, 1), Bt, bcol + HALF, t + 3);
    G8_WV(6); G8_BAR; G8_MMA(1, 1, At, B1); G8_BAR;
  }
  { G8_LDB(B0, 0, 0); G8_LDA(At, 0, 0); G8_STAGE(G8_SA(1, 1), A, brow + HALF, nt - 1);
    G8_BAR; G8_WL(0); G8_MMA(0, 0, At, B0); G8_BAR;
    G8_LDB(B1, 0, 1); G8_BAR; G8_WL(0); G8_MMA(0, 1, At, B1); G8_BAR;
    G8_LDA(At, 0, 1); G8_WV(4); G8_BAR; G8_WL(0); G8_MMA(1, 0, At, B0); G8_MMA(1, 1, At, B1); G8_BAR; }
  { G8_LDB(B0, 1, 0); G8_LDA(At, 1, 0); G8_WV(2); G8_BAR; G8_WL(0); G8_MMA(0, 0, At, B0); G8_BAR;
    G8_LDB(B1, 1, 1); G8_WV(0); G8_BAR; G8_WL(0); G8_MMA(0, 1, At, B1); G8_BAR;
    G8_LDA(At, 1, 1); G8_BAR; G8_WL(0); G8_MMA(1, 0, At, B0); G8_MMA(1, 1, At, B1); G8_BAR; }
  if (wr == 0) G8_BAR;
#undef G8_SA
#undef G8_SB
#undef G8_STAGE
#undef G8_LDA
#undef G8_LDB
#undef G8_MMA
#undef G8_WV
#undef G8_WL
#undef G8_BAR
#undef G8_SCHED
}

DI void phase_inproj(const Params& p, int layer, char* lds) {
  const u16* xb = (const u16*)(p.ws + OFF_XB);
  const u16* wt = (const u16*)(p.ws + OFF_WIN) + (size_t)layer * DIN * DM;
  u16* H = (u16*)(p.ws + OFF_H);
  int tid_ = threadIdx.x; asm volatile("" : "+v"(tid_)); const int tid = tid_, lane = tid & 63, w = tid >> 6, l32 = lane & 31, hh = lane >> 5, wm = w & 1, wn = w >> 1;
  constexpr int NTN = 11, NRB = T / 256, NTILES = NRB * NTN;
  const float SC_DQ = 0.17677669529663687f * LOG2E, SC_SQ = 0.125f * LOG2E;
  const bool xcd_ok = (gridDim.x % 8) == 0;
  const int xj = xcd_ok ? (int)(blockIdx.x & 7) : 0, nbl = xcd_ok ? (int)(gridDim.x >> 3) : (int)gridDim.x;
  const int bl = xcd_ok ? (int)(blockIdx.x >> 3) : (int)blockIdx.x, per_x = xcd_ok ? NTILES / 8 : NTILES;
  for (int u = bl; u < per_x; u += nbl) {
    const int lr = u / NTN, nt = u % NTN;
    const int mt = xcd_ok ? lr * 8 + xj : lr, m0 = mt * 256, n0 = nt * 256;
    const int nvalid = (DIN - n0) < 256 ? (DIN - n0) : 256;
    (void)nvalid;
    f32x4 acc[2][2][4][2];
#pragma unroll
    for (int ai = 0; ai < 2; ++ai)
#pragma unroll
      for (int bj = 0; bj < 2; ++bj)
#pragma unroll
        for (int m = 0; m < 4; ++m)
#pragma unroll
          for (int n = 0; n < 2; ++n) acc[ai][bj][m][n] = (f32x4){0.f, 0.f, 0.f, 0.f};
    gemm8p(xb, wt, m0, n0, acc);
    const int wr8 = w >> 2, wc8 = w & 3, fr = lane & 15, fq = lane >> 4;
#pragma unroll
    for (int bj = 0; bj < 2; ++bj)
#pragma unroll
      for (int n = 0; n < 2; ++n) {
        const int cw = n0 + bj * 128 + wc8 * 32 + n * 16, col = cw + fr;
        u16* dst = H + cw; int dstr = DIN;
        {
          const int bb = m0 / S;
          if (cw >= C_DK && cw < C_DV) { const int o = cw - C_DK; dst = (u16*)(p.ws + OFF_DK) + ((size_t)(bb * 3 * S + (o >> 6) * S) << 6) + (o & 63); dstr = 64; }
          else if (cw >= C_DV && cw < C_SQ) { const int o = cw - C_DV; dst = (u16*)(p.ws + OFF_DV) + ((size_t)(bb * 3 * S + (o >> 6) * S) << 6) + (o & 63); dstr = 64; }
          else if (cw >= C_SK && cw < C_SV) { const int o = cw - C_SK; dst = (u16*)(p.ws + OFF_SK) + ((size_t)(bb * 1 * S + (o >> 6) * S) << 6) + (o & 63); dstr = 64; }
          else if (cw >= C_SV && cw < C_GATE) { const int o = cw - C_SV; dst = (u16*)(p.ws + OFF_SV) + ((size_t)(bb * 1 * S + (o >> 6) * S) << 6) + (o & 63); dstr = 64; }
        }
        if (cw < DIN) {
          float sc = 1.f;
          if (col >= C_DQ && col < C_DK) sc = SC_DQ;
          if (col >= C_SQ && col < C_SK) sc = SC_SQ;
          const bool gate = col >= C_GATE;
#pragma unroll
          for (int ai = 0; ai < 2; ++ai)
#pragma unroll
            for (int m = 0; m < 4; ++m) {
#pragma unroll
              for (int j = 0; j < 4; ++j) {
                const int row = m0 + ai * 128 + wr8 * 64 + m * 16 + fq * 4 + j;
                float v = acc[ai][bj][m][n][j] * sc;
                if (gate) v = v * __builtin_amdgcn_rcpf(1.f + __expf(-v));
                dst[(size_t)row * dstr + fr] = f2bf(v);
              }
              __builtin_amdgcn_sched_barrier(0);
            }
        }
      }
  }
}

DI void phase_mla_up(const Params& p, int layer, char* lds) {
  const u16* H = (const u16*)(p.ws + OFF_H);
  const u16* wuq = (const u16*)(p.ws + OFF_WUQ) + (size_t)layer * 576 * 192;
  const u16* wukv = (const u16*)(p.ws + OFF_WUKV) + (size_t)layer * 768 * 128;
  const f32x2* rt = (const f32x2*)(p.ws + OFF_ROPE);
  u16* QB = (u16*)(p.ws + OFF_QB); u16* KB = (u16*)(p.ws + OFF_KB); u16* VB = (u16*)(p.ws + OFF_VB);
  int tid_ = threadIdx.x; asm volatile("" : "+v"(tid_)); const int tid = tid_, lane = tid & 63, w = tid >> 6, l32 = lane & 31, hh = lane >> 5, wm = w & 3, wn = w >> 2;
  char* As = lds; char* Bs = lds + 128 * 400; float* rinv = (float*)(lds + 256 * 400);
  const float QSC = 0.10206207261596577f * LOG2E;
  for (int item = blockIdx.x; item < T / 128; item += gridDim.x) {
    const int m0 = item * 128;
#pragma unroll 1
    for (int part = 0; part < 2; ++part) {
      const int K = part == 0 ? 192 : 128, acol = part == 0 ? C_CQ : C_CKV, STR = (K + 8) * 2, CPR = K / 8;
      const int NCT = part == 0 ? 9 : 12;
      const u16* Wt = part == 0 ? wuq : wukv;
      __syncthreads();
      for (int c = tid; c < 128 * CPR; c += NTHR) { int row = c / CPR, ch = c % CPR;
        *(u32x4*)(As + row * STR + ch * 16) = *(const u32x4*)(H + (size_t)(m0 + row) * DIN + acol + ch * 8); }
      __syncthreads();
      {
        int row = tid >> 2, part4 = tid & 3, n = K / 4; float ss = 0.f;
        const u16* ar = (const u16*)(As + row * STR) + part4 * n;
        for (int i = 0; i < n; ++i) { float v = bf2f(ar[i]); ss += v * v; }
        ss += __shfl_xor(ss, 1); ss += __shfl_xor(ss, 2);
        if (part4 == 0) rinv[row] = rsqrtf(ss / (float)K + 1e-6f);
      }
      const int NCT2 = (NCT + 1) / 2, NOUT = NCT * 64;
      u32x4 rw[6];
      auto wload = [&](int ct) {
        int tl = tid; asm volatile("" : "+v"(tl));
#pragma unroll
        for (int i = 0; i < 6; ++i) { const int c = tl + NTHR * i; if (c < 128 * CPR) rw[i] = *(const u32x4*)(Wt + (size_t)ct * 128 * K + c * 8); }
      };
      __syncthreads();
      float rv[16];
#pragma unroll
      for (int r = 0; r < 16; ++r) rv[r] = rinv[32 * wm + crow(r, hh)] * (part == 0 ? QSC : 1.f);
      const int rowb = m0 + 32 * wm + 4 * hh;
      const int bq = m0 >> 13, srow = rowb & (S - 1);
      auto epi = [&](const f32x16& acc, const int c0) {
        if (part == 0) {
          const bool is_rope = (c0 % 96 == 64);
          u16* qp = QB + (size_t)rowb * QW + c0 + l32;
          const f32x2* rp = rt + (size_t)srow * 16 + (l32 & 15);
#pragma unroll
          for (int r = 0; r < 16; ++r) {
            const int ro = (r & 3) + 8 * (r >> 2);
            float v = acc[r] * rv[r];
            if (is_rope) {
              float o = __shfl_xor(v, 16);
              f32x2 cs = rp[ro * 16];
              v = (l32 < 16) ? (v * cs[0] - o * cs[1]) : (v * cs[0] + o * cs[1]);
            }
            qp[ro * QW] = (u16)(pk2(v, 0.f) & 0xffffu);
          }
        } else {
          const int head = c0 >> 7, within = c0 & 127;
          const size_t hrow = (size_t)(bq * 6 + head) * S + srow;
          if (within < 64) {
            u16* kp = KB + hrow * 96 + within + l32;
#pragma unroll
            for (int r = 0; r < 16; ++r) kp[((r & 3) + 8 * (r >> 2)) * 96] = (u16)(pk2(acc[r] * rv[r], 0.f) & 0xffffu);
          } else {
            u16* vp = VB + hrow * 64 + (within - 64) + l32;
#pragma unroll
            for (int r = 0; r < 16; ++r) vp[((r & 3) + 8 * (r >> 2)) * 64] = (u16)(pk2(acc[r] * rv[r], 0.f) & 0xffffu);
          }
        }
      };
      wload(0);
#pragma unroll 1
      for (int ct = 0; ct < NCT2; ++ct) {
        {
          int tl = tid; asm volatile("" : "+v"(tl));
#pragma unroll
          for (int i = 0; i < 6; ++i) { const int c = tl + NTHR * i, row = c / CPR, ch = c % CPR; if (c < 128 * CPR) *(u32x4*)(Bs + row * STR + ch * 16) = rw[i]; }
        }
        LDS_BARRIER();
        if (ct + 1 < NCT2) wload(ct + 1);
        f32x16 acc0, acc1;
#pragma unroll
        for (int r = 0; r < 16; ++r) { acc0[r] = 0.f; acc1[r] = 0.f; }
#define P2_MMA(NST, STRB) do { const char* ap_ = As + (32 * wm + l32) * (STRB) + hh * 16; const char* bp_ = Bs + (64 * wn + l32) * (STRB) + hh * 16; \
          _Pragma("unroll") for (int st = 0; st < (NST); ++st) { \
            bf16x8 af = *(const bf16x8*)(ap_ + st * 32); bf16x8 b0 = *(const bf16x8*)(bp_ + st * 32); bf16x8 b1 = *(const bf16x8*)(bp_ + 32 * (STRB) + st * 32); \
            acc0 = MFMA(af, b0, acc0); acc1 = MFMA(af, b1, acc1); } } while (0)
        if (part == 0) P2_MMA(12, 400); else P2_MMA(8, 272);
#undef P2_MMA
        const int c0 = ct * 128 + 64 * wn;
        if (c0 < NOUT) epi(acc0, c0);
        if (c0 + 32 < NOUT) epi(acc1, c0 + 32);
        LDS_BARRIER();
      }
    }
    for (int idx = tid; idx < 128 * 16; idx += NTHR) {
      const int row = idx >> 4, i = idx & 15, trow = m0 + row;
      float x1 = bf2f(H[(size_t)trow * DIN + C_KR + i]), x2 = bf2f(H[(size_t)trow * DIN + C_KR + 16 + i]);
      f32x2 cs = rt[(size_t)(trow & (S - 1)) * 16 + i];
      u16 o1 = f2bf(x1 * cs[0] - x2 * cs[1]), o2 = f2bf(x2 * cs[0] + x1 * cs[1]);
#pragma unroll
      for (int hd = 0; hd < 6; ++hd) { const size_t hrow = (size_t)((trow >> 13) * 6 + hd) * S + (trow & (S - 1)); KB[hrow * 96 + 64 + i] = o1; KB[hrow * 96 + 80 + i] = o2; }
    }
  }
}

constexpr int VSTR = 192;
template <int OFF>
DI void trread8(unsigned addr, s16x4 (&v)[8]) {
  asm volatile(
      "ds_read_b64_tr_b16 %0, %8 offset:%9\n\t"
      "ds_read_b64_tr_b16 %1, %8 offset:%10\n\t"
      "ds_read_b64_tr_b16 %2, %8 offset:%11\n\t"
      "ds_read_b64_tr_b16 %3, %8 offset:%12\n\t"
      "ds_read_b64_tr_b16 %4, %8 offset:%13\n\t"
      "ds_read_b64_tr_b16 %5, %8 offset:%14\n\t"
      "ds_read_b64_tr_b16 %6, %8 offset:%15\n\t"
      "ds_read_b64_tr_b16 %7, %8 offset:%16\n\t"
      "s_waitcnt lgkmcnt(0)"
      : "=&v"(v[0]), "=&v"(v[1]), "=&v"(v[2]), "=&v"(v[3]), "=&v"(v[4]), "=&v"(v[5]), "=&v"(v[6]), "=&v"(v[7])
      : "v"(addr), "i"(OFF + 0 * VSTR + 0), "i"(OFF + 8 * VSTR + 0), "i"(OFF + 0 * VSTR + 64), "i"(OFF + 8 * VSTR + 64),
        "i"(OFF + 16 * VSTR + 0), "i"(OFF + 24 * VSTR + 0), "i"(OFF + 16 * VSTR + 64), "i"(OFF + 24 * VSTR + 64)
      : "memory");
}

template <int MODE>
DI void attn_item(const Params& p, int layer, int bh, int qb, char* lds) {
  constexpr int KD = MODE == 0 ? 96 : 64, NMAP = MODE == 1 ? 2 : 1, QS = MODE == 0 ? 6 : (MODE == 1 ? 2 : 4);
  constexpr int KSTR = KD * 2 + 16, KBYTES = 64 * KSTR, VBYTES = 64 * VSTR, STAGE = KBYTES + VBYTES, KCH = (8 * KD + NTHR - 1) / NTHR, KCPR = KD / 8, KCHUNKS = 8 * KD;
  constexpr int BREL_BYTES = 2048;
  int tid_ = threadIdx.x; asm volatile("" : "+v"(tid_)); const int tid = tid_, lane = tid & 63, w = tid >> 6, l32 = lane & 31, hh = lane >> 5;
  const int q0 = qb * 256, q0w = q0 + 32 * w;
  const u16 *Qg, *Kg, *Vg; int qstr, kstr, vstr, ocol, b, hd;
  if (MODE == 0) {
    b = bh / 6; hd = bh % 6;
    Qg = (const u16*)(p.ws + OFF_QB) + (size_t)b * S * QW + hd * 96; qstr = QW;
    Kg = (const u16*)(p.ws + OFF_KB) + (size_t)(b * 6 + hd) * S * 96; kstr = 96;
    Vg = (const u16*)(p.ws + OFF_VB) + (size_t)(b * 6 + hd) * S * 64; vstr = 64;
    ocol = hd * 64;
  } else if (MODE == 1) {
    b = bh / 4; hd = bh % 4;
    const u16* Hb = (const u16*)(p.ws + OFF_H) + (size_t)b * S * DIN;
    Qg = Hb + C_DQ + hd * 64; qstr = DIN; kstr = vstr = 64;
    Kg = (const u16*)(p.ws + OFF_DK) + (size_t)(b * 4 + hd) * S * 64; Vg = (const u16*)(p.ws + OFF_DV) + (size_t)(b * 4 + hd) * S * 64;
    ocol = 384 + hd * 64;
  } else {
    b = bh / 6; hd = bh % 6;
    const u16* Hb = (const u16*)(p.ws + OFF_H) + (size_t)b * S * DIN;
    Qg = Hb + C_SQ + hd * 64; qstr = DIN; kstr = vstr = 64;
    Kg = (const u16*)(p.ws + OFF_SK) + (size_t)(b * 2 + hd / 3) * S * 64; Vg = (const u16*)(p.ws + OFF_SV) + (size_t)(b * 2 + hd / 3) * S * 64;
    ocol = 640 + hd * 64;
  }
  float* brel = (float*)lds;
  char* stage0 = lds + BREL_BYTES;
  if (MODE != 0) {
    const int bcol = MODE == 1 ? hd : 4 + hd;
    for (int i = tid; i < 512; i += NTHR) {
      int rel = i - 224, rc = rel < -128 ? -128 : (rel > 128 ? 128 : rel);
      float bv = p.relb[t5_bucket(rc) * 10 + bcol] * LOG2E;
      brel[i] = (MODE == 2 && rc != rel) ? -1e30f : bv;
    }
  }
  bf16x8 qf[NMAP][QS];
  {
    const u16* qrow = Qg + (size_t)(q0w + l32) * qstr + hh * 8;
#pragma unroll
    for (int mp = 0; mp < NMAP; ++mp)
#pragma unroll
      for (int st = 0; st < QS; ++st) qf[mp][st] = *(const bf16x8*)(qrow + (mp * QS + st) * 16);
  }
  f32x16 O[NMAP][2]; float m = 0.f, l[NMAP];
#pragma unroll
  for (int mp = 0; mp < NMAP; ++mp) {
#pragma unroll
    for (int r = 0; r < 16; ++r) { O[mp][0][r] = 0.f; O[mp][1][r] = 0.f; }
    l[mp] = 0.f;
  }
  if (MODE == 2) { m = p.sink[layer * 6 + hd] * LOG2E; l[0] = (hh == 0) ? 1.f : 0.f; }
  int kt0 = 0, kt1 = S / 64;
  if (MODE == 2) { kt0 = (q0 - 128) / 64; if (kt0 < 0) kt0 = 0; kt1 = (q0 + 384) / 64; if (kt1 > S / 64) kt1 = S / 64; }
  const int nt = kt1 - kt0;
  constexpr int KSTRG = MODE == 0 ? 96 : 64, VSTRG = 64;
  u32x4 rkA[KCH], rvA[1], rkB[KCH], rvB[1];
  const __amdgpu_buffer_rsrc_t krsrc = __builtin_amdgcn_make_buffer_rsrc((void*)Kg, 0, S * KSTRG * 2, 0x00027000);
  const __amdgpu_buffer_rsrc_t vrsrc = __builtin_amdgcn_make_buffer_rsrc((void*)Vg, 0, S * VSTRG * 2, 0x00027000);
  auto gload = [&](int kt, u32x4 (&rk)[KCH], u32x4 (&rv)[1]) {
    const int ksoff = kt * (64 * KSTRG * 2), vsoff = kt * (64 * VSTRG * 2);
#pragma unroll
    for (int i = 0; i < KCH; ++i) if (tid + NTHR * i < KCHUNKS) rk[i] = __builtin_amdgcn_raw_buffer_load_b128(krsrc, tid * 16 + NTHR * 16 * i, ksoff, 0);
    rv[0] = __builtin_amdgcn_raw_buffer_load_b128(vrsrc, tid * 16, vsoff, 0);
  };
  auto lstore = [&](int st, const u32x4 (&rk)[KCH], const u32x4 (&rv)[1]) {
    char* Ks = stage0 + st * STAGE;
#pragma unroll
    for (int i = 0; i < KCH; ++i) { int c = tid + NTHR * i, row = c / KCPR, ch = c % KCPR; if (c < KCHUNKS) *(u32x4*)(Ks + row * KSTR + ch * 16) = rk[i]; }
    { int row = tid >> 3, ch = tid & 7; *(u32x4*)(Ks + KBYTES + row * VSTR + ch * 16) = rv[0]; }
  };
  const unsigned vlane = (unsigned)((4 * hh + ((lane & 15) >> 2)) * VSTR + 32 * ((lane >> 4) & 1) + 8 * (lane & 3));
  bf16x8 kaug, qaug;
  { u32x4 tk = {hh == 0 ? 0x3F803F80u : 0u, 0u, 0u, 0u}; kaug = __builtin_bit_cast(bf16x8, tk); qaug = __builtin_bit_cast(bf16x8, (u32x4){0u, 0u, 0u, 0u}); }
  f32x16 c0p;
  auto set_c0 = [&](float c0) {
    const unsigned hi = f2bf(c0); const unsigned lo = f2bf(c0 - bf2f((u16)hi));
    u32x4 tq = {hh == 0 ? (hi | (lo << 16)) : 0u, 0u, 0u, 0u}; qaug = __builtin_bit_cast(bf16x8, tq);
    { const f32x16 z16 = {0.f, 0.f, 0.f, 0.f, 0.f, 0.f, 0.f, 0.f, 0.f, 0.f, 0.f, 0.f, 0.f, 0.f, 0.f, 0.f}; c0p = MFMA(kaug, qaug, z16); }
  };
  int c0cls = -1;
  auto compute = [&](const int t, const int cur) {
    const int k0 = (kt0 + t) * 64;
    const char* Ks = stage0 + cur * STAGE;
    bool active = true;
    if (MODE == 2) active = (k0 + 63 >= q0w - 128) && (k0 <= q0w + 159);
    if (active) {
      const float* brow = brel + (k0 - q0w - l32 + 4 * hh + 224);
      int cls = 0; float cb = 0.f;
      if (MODE == 1) {
        const int rmax = k0 + 63 - q0w, rmin = k0 - (q0w + 31);
        if (rmax <= -128) { cls = 1; cb = brel[224 - 128]; }
        else if (rmin >= 128) { cls = 2; cb = brel[224 + 128]; }
      }
      const bool far = cls != 0;
      if (cls != c0cls) { c0cls = cls; set_c0(cb - m); }
      const unsigned vaddr = (unsigned)(uintptr_t)(Ks + KBYTES) + vlane;
      typedef __attribute__((address_space(3))) s16x4 lds_s16x4;
      s16x4 vpre[16];
      u32x4 pk[NMAP][2][2];
#pragma unroll
      for (int mp = 0; mp < NMAP; ++mp) {
        f32x16 s[2];
        const f32x16 zero16 = {0.f, 0.f, 0.f, 0.f, 0.f, 0.f, 0.f, 0.f, 0.f, 0.f, 0.f, 0.f, 0.f, 0.f, 0.f, 0.f};
        __builtin_amdgcn_s_setprio(1);
        f32x16 c0tile;
        c0tile = c0p;
#pragma unroll
        for (int sub = 0; sub < 2; ++sub) {
#pragma unroll
          for (int st = 0; st < QS; ++st) {
            bf16x8 kf = *(const bf16x8*)(Ks + (32 * sub + l32) * KSTR + ((mp * QS + st) * 16 + hh * 8) * 2);
            if (st == 0) s[sub] = MFMA(kf, qf[mp][st], c0tile); else s[sub] = MFMA(kf, qf[mp][st], s[sub]);
          }
        }
        __builtin_amdgcn_iglp_opt(1);
        __builtin_amdgcn_s_setprio(0);
        if (NMAP == 1) {
          lds_s16x4* vb = (lds_s16x4*)(Ks + KBYTES + vlane);
#pragma unroll
          for (int i = 0; i < 16; ++i) {
            const int sub_ = i >> 3, ks_ = (i >> 2) & 1, dt_ = (i >> 1) & 1, g_ = i & 1;
            vpre[i] = __builtin_amdgcn_ds_read_tr16_b64_v4i16(vb + ((32 * sub_ + 16 * ks_ + 8 * g_) * VSTR + 64 * dt_) / 8);
          }
          __builtin_amdgcn_sched_barrier(0);
        }
        if (MODE != 0 && !far) {
#pragma unroll
          for (int sub = 0; sub < 2; ++sub)
#pragma unroll
            for (int r = 0; r < 16; ++r) s[sub][r] += brow[32 * sub + (r & 3) + 8 * (r >> 2)];
        }
        const bool first = (MODE != 2) && (t == 0) && (mp == 0);
        auto rebase = [&]() {
          float mx = fmaxf(fmaxf(s[0][0], s[0][1]), s[0][2]);
#pragma unroll
          for (int r = 3; r < 15; r += 2) mx = fmaxf(fmaxf(mx, s[0][r]), s[0][r + 1]);
          mx = fmaxf(mx, s[0][15]);
#pragma unroll
          for (int r = 0; r < 16; r += 2) mx = fmaxf(fmaxf(mx, s[1][r]), s[1][r + 1]);
          const float rm = xchg_max(mx);
          float delta = first ? rm : fmaxf(rm, 0.f);
          if (delta < -1e29f) delta = 0.f;
          m += delta;
          const float alpha = __builtin_amdgcn_exp2f(-delta);
#pragma unroll
          for (int mq = 0; mq < NMAP; ++mq) {
            l[mq] *= alpha;
#pragma unroll
            for (int r = 0; r < 16; ++r) { O[mq][0][r] *= alpha; O[mq][1][r] *= alpha; }
          }
#pragma unroll
          for (int r = 0; r < 16; ++r) { s[0][r] -= delta; s[1][r] -= delta; }
          set_c0(cb - m);
        };
        float ps;
        auto smpass = [&]() {
          ps = 0.f;
#pragma unroll
          for (int sub = 0; sub < 2; ++sub)
#pragma unroll
            for (int ks = 0; ks < 2; ++ks)
#pragma unroll
              for (int i = 0; i < 4; ++i) {
                const float p0 = __builtin_amdgcn_exp2f(s[sub][8 * ks + 2 * i]), p1 = __builtin_amdgcn_exp2f(s[sub][8 * ks + 2 * i + 1]);
                ps += p0 + p1; pk[mp][sub][ks][i] = pk2(p0, p1);
              }
        };
        if (first) rebase();
        smpass();
        if (!first && __any(!(ps <= PSLIM))) { rebase(); smpass(); }
        l[mp] += ps;
        __builtin_amdgcn_sched_barrier(0);
      }
#pragma unroll
      for (int sub = 0; sub < 2; ++sub) {
        s16x4 vv[8];
        if (NMAP == 1) {
#pragma unroll
          for (int i = 0; i < 8; ++i) vv[i] = vpre[sub * 8 + i];
        } else {
          if (sub == 0) trread8<0>(vaddr, vv); else trread8<32 * VSTR>(vaddr, vv);
        }
        __builtin_amdgcn_s_setprio(1);
#pragma unroll
        for (int ks = 0; ks < 2; ++ks) {
#pragma unroll
          for (int dt = 0; dt < 2; ++dt) {
            s16x4 lo = vv[ks * 4 + dt * 2], hi = vv[ks * 4 + dt * 2 + 1];
            bf16x8 vf = __builtin_shufflevector(lo, hi, 0, 1, 2, 3, 4, 5, 6, 7);
#pragma unroll
            for (int mp = 0; mp < NMAP; ++mp) O[mp][dt] = MFMA(vf, __builtin_bit_cast(bf16x8, pk[mp][sub][ks]), O[mp][dt]);
          }
        }
        __builtin_amdgcn_s_setprio(0);
        __builtin_amdgcn_sched_barrier(0);
      }
    }
  };
  __syncthreads();
  gload(kt0, rkA, rvA); lstore(0, rkA, rvA);
  if (nt > 1) gload(kt0 + 1, rkB, rvB);
  LDS_BARRIER();
  for (int t = 0; t < nt; t += 2) {
    if (t + 2 < nt) gload(kt0 + t + 2, rkA, rvA);
    compute(t, 0);
    if (t + 1 < nt) lstore(1, rkB, rvB);
    LDS_BARRIER();
    if (t + 1 >= nt) break;
    if (t + 3 < nt) gload(kt0 + t + 3, rkB, rvB);
    compute(t + 1, 1);
    if (t + 2 < nt) lstore(0, rkA, rvA);
    LDS_BARRIER();
  }
  __syncthreads();
  const size_t trow = (size_t)b * S + q0w + l32;
  const u16* grow = (const u16*)(p.ws + OFF_H) + trow * DIN + C_GATE + ocol;
  u16* orow = (u16*)(p.ws + OFF_OB) + trow * DM + ocol;
  float inv0 = 1.f / xchg_sum(l[0]);
  if (MODE == 1) {
    const float* lm = (const float*)(p.ws + OFF_LAM);
    const float lam = lm[layer], post = lm[4 + layer];
    const float inv1 = lam / xchg_sum(l[1]);
    float ss = 0.f;
#pragma unroll
    for (int dt = 0; dt < 2; ++dt)
#pragma unroll
      for (int r = 0; r < 16; ++r) { float v = O[0][dt][r] * inv0 - O[NMAP - 1][dt][r] * inv1; O[0][dt][r] = v; ss += v * v; }
    ss = xchg_sum(ss);
    inv0 = rsqrtf(ss * (1.f / 64.f) + 1e-6f) * post;
  }
#pragma unroll
  for (int dt = 0; dt < 2; ++dt)
#pragma unroll
    for (int g = 0; g < 4; ++g) {
      const int d = 32 * dt + 8 * g + 4 * hh;
      u32x2 gw = *(const u32x2*)(grow + d);
      float v0 = O[0][dt][4 * g + 0] * inv0, v1 = O[0][dt][4 * g + 1] * inv0, v2 = O[0][dt][4 * g + 2] * inv0, v3 = O[0][dt][4 * g + 3] * inv0;
      if (MODE == 1) { const float* sl = p.subln + layer * 64 + d; v0 *= sl[0]; v1 *= sl[1]; v2 *= sl[2]; v3 *= sl[3]; }
      v0 *= bflo(gw[0]); v1 *= bfhi(gw[0]); v2 *= bflo(gw[1]); v3 *= bfhi(gw[1]);
      u32x2 ow = {pk2(v0, v1), pk2(v2, v3)};
#ifdef PROBE_ZERO_MODE
      if (MODE == PROBE_ZERO_MODE) { ow[0] = 0u; ow[1] = 0u; }
#endif
      *(u32x2*)(orow + d) = ow;
    }
}

DI void phase_attn(const Params& p, int layer, char* lds) {
  constexpr int N_MLA = 24 * 32, N_DIFF = 16 * 32, N_SWA = 24 * 32;
  for (int g = blockIdx.x; g < N_MLA + N_DIFF + N_SWA; g += gridDim.x) {
    if (g < N_MLA) { int i = g; attn_item<0>(p, layer, (i & 7) + 8 * (i >> 8), (i >> 3) & 31, lds); }
    else if (g < N_MLA + N_DIFF) { int i = g - N_MLA; attn_item<1>(p, layer, (i & 7) + 8 * (i >> 8), (i >> 3) & 31, lds); }
    else { int i = g - N_MLA - N_DIFF; attn_item<2>(p, layer, (i & 7) + 8 * (i >> 8), (i >> 3) & 31, lds); }
  }
}

DI void phase_outproj(const Params& p, int layer, char* lds) {
  const u16* ob = (const u16*)(p.ws + OFF_OB);
  const u16* wt = (const u16*)(p.ws + OFF_WOUT) + (size_t)layer * DM * DM;
  const float* xres = layer == 0 ? p.x : p.out;
  float* xout = p.out;
  int tid_ = threadIdx.x; asm volatile("" : "+v"(tid_)); const int tid = tid_, lane = tid & 63, w = tid >> 6, l32 = lane & 31, hh = lane >> 5, wm = w & 1, wn = w >> 1;
  constexpr int NTN = DM / 256, NRB = T / 256, NTILES = NRB * NTN;
  const bool xcd_ok = (gridDim.x % 8) == 0;
  const int xj = xcd_ok ? (int)(blockIdx.x & 7) : 0, nbl = xcd_ok ? (int)(gridDim.x >> 3) : (int)gridDim.x;
  const int bl = xcd_ok ? (int)(blockIdx.x >> 3) : (int)blockIdx.x, per_x = xcd_ok ? NTILES / 8 : NTILES;
  for (int u = bl; u < per_x; u += nbl) {
    const int lr = u / NTN, nt = u % NTN, mt = xcd_ok ? lr * 8 + xj : lr, m0 = mt * 256, n0 = nt * 256;
    const int wr8 = w >> 2, wc8 = w & 3, fr = lane & 15, fq = lane >> 4;
    const size_t base = (size_t)(m0 + wr8 * 64 + fq * 4) * DM + (n0 + wc8 * 32 + fr);
    f32x4 acc[2][2][4][2];
#pragma unroll
    for (int ai = 0; ai < 2; ++ai)
#pragma unroll
      for (int bj = 0; bj < 2; ++bj)
#pragma unroll
        for (int m = 0; m < 4; ++m)
#pragma unroll
          for (int n = 0; n < 2; ++n) acc[ai][bj][m][n] = (f32x4){0.f, 0.f, 0.f, 0.f};
    gemm8p(ob, wt, m0, n0, acc);
    u16* yo = (u16*)(p.ws + OFF_XB) + base;
#pragma unroll
    for (int ai = 0; ai < 2; ++ai)
#pragma unroll
      for (int bj = 0; bj < 2; ++bj)
#pragma unroll
        for (int m = 0; m < 4; ++m) {
#pragma unroll
          for (int n = 0; n < 2; ++n)
#pragma unroll
            for (int j = 0; j < 4; ++j) yo[(ai * 128 + m * 16 + j) * DM + bj * 128 + n * 16] = f2bf(acc[ai][bj][m][n][j]);
          __builtin_amdgcn_sched_barrier(0);
        }
  }
}

DI void phase_ln(const Params& p, int layer) {
  const float* xres = layer == 0 ? p.x : p.out;
  float* xout = p.out;
  u16* xb = (u16*)(p.ws + OFF_XB);
  const float* lg = p.ln_g + layer * DM; const float* lb = p.ln_b + layer * DM;
  int tid_ = threadIdx.x; asm volatile("" : "+v"(tid_)); const int tid = tid_, lane = tid & 63, w = tid >> 6;
#pragma unroll 1
  for (size_t row = (size_t)blockIdx.x * 8 + w; row < (size_t)T; row += (size_t)gridDim.x * 8) {
    f32x4 v[4]; float sum = 0.f;
#pragma unroll
    for (int i = 0; i < 4; ++i) {
      const f32x4 xv = *(const f32x4*)(xres + row * DM + 4 * lane + 256 * i);
      const u32x2 yw = *(const u32x2*)(xb + row * DM + 4 * lane + 256 * i);
      v[i][0] = ALPHA * xv[0] + bflo(yw[0]); v[i][1] = ALPHA * xv[1] + bfhi(yw[0]); v[i][2] = ALPHA * xv[2] + bflo(yw[1]); v[i][3] = ALPHA * xv[3] + bfhi(yw[1]);
      sum += v[i][0] + v[i][1] + v[i][2] + v[i][3];
    }
    const float mu = wave_sum(sum) * (1.f / DM);
    float sq = 0.f;
#pragma unroll
    for (int i = 0; i < 4; ++i)
#pragma unroll
      for (int j = 0; j < 4; ++j) { float d = v[i][j] - mu; sq += d * d; }
    const float rstd = rsqrtf(wave_sum(sq) * (1.f / DM) + 1e-5f);
#pragma unroll
    for (int i = 0; i < 4; ++i) {
      const int col = 4 * lane + 256 * i;
      f32x4 g = *(const f32x4*)(lg + col), bb = *(const f32x4*)(lb + col), o;
#pragma unroll
      for (int j = 0; j < 4; ++j) o[j] = (v[i][j] - mu) * rstd * g[j] + bb[j];
      *(f32x4*)(xout + row * DM + col) = o;
      if (layer + 1 < DEPTH) {
        u32x2 ow = {pk2(o[0], o[1]), pk2(o[2], o[3])};
        *(u32x2*)(xb + row * DM + col) = ow;
      }
    }
  }
}

#if MK_COOP
DI void fast_grid_sync(unsigned* ctr, unsigned& epoch) {
  asm volatile("s_waitcnt vmcnt(0) lgkmcnt(0)" ::: "memory");
  __syncthreads();
  epoch += 1u;
  if (threadIdx.x == 0) {
    __builtin_amdgcn_fence(__ATOMIC_RELEASE, "agent");
    asm volatile("s_waitcnt vmcnt(0)" ::: "memory");
    const unsigned target = epoch * gridDim.x;
    (void)__hip_atomic_fetch_add(ctr, 1u, __ATOMIC_RELAXED, __HIP_MEMORY_SCOPE_AGENT);
    unsigned spins = 0;
    while (__hip_atomic_load(ctr, __ATOMIC_RELAXED, __HIP_MEMORY_SCOPE_AGENT) < target) {
      __builtin_amdgcn_s_sleep(2);
      if (++spins > (1u << 26)) break;
    }
    __builtin_amdgcn_fence(__ATOMIC_ACQUIRE, "agent");
    asm volatile("s_waitcnt vmcnt(0)" ::: "memory");
  }
  __syncthreads();
}

__global__ void __launch_bounds__(NTHR) fwd_megakernel(Params p) {
  char* lds = lds_dyn;
  cg::grid_group grid = cg::this_grid();
  unsigned* bar_ctr = (unsigned*)(p.ws + OFF_BAR); unsigned bar_epoch = 0;
  phase_prep(p, lds);
  grid.sync();
  for (int layer = 0; layer < DEPTH; ++layer) {
    phase_inproj(p, layer, lds);
    fast_grid_sync(bar_ctr, bar_epoch);
    phase_mla_up(p, layer, lds);
    fast_grid_sync(bar_ctr, bar_epoch);
#ifdef PROBE_REP_P12
    phase_inproj(p, layer, lds);
    fast_grid_sync(bar_ctr, bar_epoch);
    phase_mla_up(p, layer, lds);
    fast_grid_sync(bar_ctr, bar_epoch);
#endif
#ifdef PROBE_REP_P2
    phase_mla_up(p, layer, lds);
    fast_grid_sync(bar_ctr, bar_epoch);
#endif
    phase_attn(p, layer, lds);
#ifdef PROBE_REP_ATTN
    fast_grid_sync(bar_ctr, bar_epoch);
    phase_attn(p, layer, lds);
#endif
    fast_grid_sync(bar_ctr, bar_epoch);
    phase_outproj(p, layer, lds);
    fast_grid_sync(bar_ctr, bar_epoch);
    phase_ln(p, layer);
    if (layer + 1 < DEPTH) fast_grid_sync(bar_ctr, bar_epoch);
  }
}
#else
template <int PH>
__global__ void __launch_bounds__(NTHR, 2) phase_kernel(Params p, int layer) {
  __shared__ __attribute__((aligned(16))) char lds[LDS_BYTES];
  if (PH == 0) phase_prep(p, lds);
  if (PH == 1) phase_inproj(p, layer, lds);
  if (PH == 2) phase_mla_up(p, layer, lds);
  if (PH == 3) phase_attn(p, layer, lds);
  if (PH == 4) phase_outproj(p, layer, lds);
  if (PH == 5) phase_ln(p, layer);
}
#endif

extern "C" void kernel_launch(void* const* d_in, const int* in_sizes, int n_in, void* d_out, int out_size, void* d_ws, size_t ws_size,
                              hipStream_t stream) {
  if (n_in != 13 || ws_size < WS_END || out_size != T * DM) {
    fprintf(stderr, "kernel_launch: unexpected shapes n_in %d ws %zu (need %zu) out %d\n", n_in, ws_size, WS_END, out_size);
    return;
  }
  Params p{};
  p.x = (const float*)d_in[0]; p.w_in = (const float*)d_in[1]; p.qn = (const float*)d_in[2]; p.kvn = (const float*)d_in[3];
  p.w_uq = (const float*)d_in[4]; p.w_ukv = (const float*)d_in[5]; p.lamv = (const float*)d_in[6]; p.subln = (const float*)d_in[7];
  p.sink = (const float*)d_in[8]; p.relb = (const float*)d_in[9]; p.w_out = (const float*)d_in[10]; p.ln_g = (const float*)d_in[11];
  p.ln_b = (const float*)d_in[12]; p.out = (float*)d_out; p.ws = (char*)d_ws;
#if MK_COOP
  static int grid_blocks = 0;
  if (!grid_blocks) {
    int dev = 0, cus = 0, per_cu = 0;
    hipGetDevice(&dev);
    hipDeviceGetAttribute(&cus, hipDeviceAttributeMultiprocessorCount, dev);
    if (hipFuncSetAttribute((const void*)fwd_megakernel, hipFuncAttributeMaxDynamicSharedMemorySize, LDS_BYTES) != hipSuccess)
      fprintf(stderr, "kernel_launch: hipFuncSetAttribute(%d B dynamic LDS) failed\n", LDS_BYTES);
    hipOccupancyMaxActiveBlocksPerMultiprocessor(&per_cu, fwd_megakernel, NTHR, LDS_BYTES);
    (void)hipGetLastError();
    (void)per_cu;
    grid_blocks = cus;
  }
  (void)hipMemsetAsync((char*)d_ws + OFF_BAR, 0, 256, stream);
  void* args[] = {&p};
  hipError_t e = hipLaunchCooperativeKernel((void*)fwd_megakernel, dim3(grid_blocks), dim3(NTHR), args, LDS_BYTES, stream);
  if (e != hipSuccess) fprintf(stderr, "cooperative launch failed: %s (grid %d)\n", hipGetErrorString(e), grid_blocks);
#else
  const int G = 512;
  hipLaunchKernelGGL(phase_kernel<0>, dim3(G), dim3(NTHR), 0, stream, p, 0);
  for (int l = 0; l < DEPTH; ++l) {
    hipLaunchKernelGGL(phase_kernel<1>, dim3(G), dim3(NTHR), 0, stream, p, l);
    hipLaunchKernelGGL(phase_kernel<2>, dim3(G), dim3(NTHR), 0, stream, p, l);
    hipLaunchKernelGGL(phase_kernel<3>, dim3(G), dim3(NTHR), 0, stream, p, l);
    hipLaunchKernelGGL(phase_kernel<4>, dim3(G), dim3(NTHR), 0, stream, p, l);
    hipLaunchKernelGGL(phase_kernel<5>, dim3(G), dim3(NTHR), 0, stream, p, l);
  }
#endif
}
```

```cpp
#include <hip/hip_runtime.h>
#include <hip/hip_cooperative_groups.h>
#include <cstdio>
#include <cstdint>
namespace cg = cooperative_groups;

#ifndef MK_COOP
#define MK_COOP 1
#endif

#define DI __device__ __forceinline__
typedef unsigned short u16;
using bf16x8 = __attribute__((ext_vector_type(8))) short;
using s16x4  = __attribute__((ext_vector_type(4))) short;
using f32x16 = __attribute__((ext_vector_type(16))) float;
using f32x4  = __attribute__((ext_vector_type(4))) float;
using f32x2  = __attribute__((ext_vector_type(2))) float;
using u32x4  = __attribute__((ext_vector_type(4))) unsigned;
using u32x2  = __attribute__((ext_vector_type(2))) unsigned;
using b16x2  = __attribute__((ext_vector_type(2))) __bf16;
#define MFMA(a, b, c) __builtin_amdgcn_mfma_f32_32x32x16_bf16((a), (b), (c), 0, 0, 0)

constexpr int NB = 4, S = 8192, T = NB * S, DM = 1024, DIN = 2784, DEPTH = 4;
constexpr int C_CQ = 0, C_CKV = 192, C_KR = 320, C_DQ = 352, C_DK = 608, C_DV = 864, C_SQ = 1120, C_SK = 1504, C_SV = 1632, C_GATE = 1760;
constexpr int QW = 576, KW = 576, VW = 384;
constexpr float LOG2E = 1.4426950408889634f;
constexpr float ALPHA = 1.681792830507429f;
constexpr int NTHR = 512;
constexpr float PSLIM = 4096.0f;

constexpr size_t SZ_WIN = (size_t)DEPTH * DIN * DM * 2, SZ_WOUT = (size_t)DEPTH * DM * DM * 2;
constexpr size_t SZ_WUQ = (size_t)DEPTH * 576 * 192 * 2, SZ_WUKV = (size_t)DEPTH * 768 * 128 * 2;
constexpr size_t SZ_ROPE = (size_t)S * 16 * 8, SZ_LAM = 256;
constexpr size_t SZ_XB = (size_t)T * DM * 2, SZ_H = (size_t)T * DIN * 2, SZ_QB = (size_t)T * QW * 2, SZ_KB = (size_t)T * KW * 2;
constexpr size_t SZ_VB = (size_t)T * VW * 2, SZ_OB = (size_t)T * DM * 2, SZ_DK = (size_t)T * 256 * 2, SZ_SK = (size_t)T * 128 * 2;
constexpr size_t OFF_WIN = 0, OFF_WOUT = OFF_WIN + SZ_WIN, OFF_WUQ = OFF_WOUT + SZ_WOUT, OFF_WUKV = OFF_WUQ + SZ_WUQ;
constexpr size_t OFF_ROPE = OFF_WUKV + SZ_WUKV, OFF_LAM = OFF_ROPE + SZ_ROPE, OFF_XB = OFF_LAM + SZ_LAM, OFF_H = OFF_XB + SZ_XB;
constexpr size_t OFF_QB = OFF_H + SZ_H, OFF_KB = OFF_QB + SZ_QB, OFF_VB = OFF_KB + SZ_KB, OFF_OB = OFF_VB + SZ_VB, OFF_DK = OFF_OB + SZ_OB, OFF_DV = OFF_DK + SZ_DK, OFF_SK = OFF_DV + SZ_DK, OFF_SV = OFF_SK + SZ_SK, OFF_BAR = OFF_SV + SZ_SK, WS_END = OFF_BAR + 256;

struct Params {
  const float *x, *w_in, *qn, *kvn, *w_uq, *w_ukv, *lamv, *subln, *sink, *relb, *w_out, *ln_g, *ln_b;
  float* out;
  char* ws;
};

extern __shared__ __attribute__((aligned(16))) char lds_dyn[];
constexpr int LDS_BYTES = 147456;

DI u16 f2bf(float x) { unsigned u = __float_as_uint(x); u += 0x7fffu + ((u >> 16) & 1u); return (u16)(u >> 16); }
DI float bf2f(u16 b) { return __uint_as_float(((unsigned)b) << 16); }
DI unsigned pk2(float lo, float hi) { f32x2 v = {lo, hi}; b16x2 r = __builtin_convertvector(v, b16x2); return __builtin_bit_cast(unsigned, r); }
DI float bflo(unsigned w) { return __uint_as_float(w << 16); }
DI float bfhi(unsigned w) { return __uint_as_float(w & 0xffff0000u); }
DI int crow(int r, int hh) { return (r & 3) + 8 * (r >> 2) + 4 * hh; }
DI float xchg_max(float v) {
  auto rr = __builtin_amdgcn_permlane32_swap(__float_as_uint(v), __float_as_uint(v), false, false);
  return fmaxf(__uint_as_float(rr[0]), __uint_as_float(rr[1]));
}
DI float xchg_sum(float v) {
  auto rr = __builtin_amdgcn_permlane32_swap(__float_as_uint(v), __float_as_uint(v), false, false);
  return __uint_as_float(rr[0]) + __uint_as_float(rr[1]);
}
DI float wave_sum(float v) {
  for (int o = 32; o >= 1; o >>= 1) v += __shfl_xor(v, o);
  return v;
}
DI int t5_bucket(int rel) {
  int n = rel < 0 ? -rel : rel;
  int b;
  if (n < 8) b = n;
  else b = 8 + (n >= 12) + (n >= 16) + (n >= 23) + (n >= 32) + (n >= 46) + (n >= 64) + (n >= 91);
  return b + (rel > 0 ? 16 : 0);
}
DI bf16x8 pack8(const f32x16& x, int s8) {
  u32x4 p = {pk2(x[s8 + 0], x[s8 + 1]), pk2(x[s8 + 2], x[s8 + 3]), pk2(x[s8 + 4], x[s8 + 5]), pk2(x[s8 + 6], x[s8 + 7])};
  return __builtin_bit_cast(bf16x8, p);
}

__device__ __constant__ float ROPE_FREQ[16] = {
  1.0f, 0.5623413324356079f, 0.3162277638912201f, 0.17782793939113617f, 0.10000000149011612f, 0.05623413249850273f,
  0.03162277489900589f, 0.017782794311642647f, 0.009999999776482582f, 0.005623413249850273f, 0.003162277629598975f,
  0.0017782794311642647f, 0.0010000000474974513f, 0.000562341301701963f, 0.0003162277571391314f, 0.00017782794020604342f};

DI void prep_transpose_tile(const float* __restrict__ src, u16* __restrict__ dst, int R, int C, const float* __restrict__ g, int tr, int tc, float* lds) {
  int tid_ = threadIdx.x; asm volatile("" : "+v"(tid_)); const int tid = tid_;
  for (int i = tid; i < 4096; i += NTHR) {
    int r = i >> 6, c = i & 63, gr = tr * 64 + r, gc = tc * 64 + c;
    float v = 0.f;
    if (gr < R && gc < C) { v = src[(size_t)gr * C + gc]; if (g) v *= g[gr]; }
    lds[r * 65 + c] = v;
  }
  __syncthreads();
  for (int i = tid; i < 4096; i += NTHR) {
    int c = i >> 6, r = i & 63, gr = tr * 64 + r, gc = tc * 64 + c;
    if (gr < R && gc < C) dst[(size_t)gc * R + gr] = f2bf(lds[r * 65 + c]);
  }
  __syncthreads();
}

DI void sincos_d(double a, float& c, float& s) {
  const double TWO_PI = 6.283185307179586476925286766559, INV_TWO_PI = 0.15915494309189533576888376337251;
  double n = rint(a * INV_TWO_PI);
  double r = fma(-n, TWO_PI, a);
  r = fma(-n, 2.4492935982947064e-16, r);
  double r2 = r * r;
  double sp = 1.0 / 15511210043330985984000000.0;
  sp = fma(sp, r2, -1.0 / 25852016738884976640000.0);
  sp = fma(sp, r2, 1.0 / 51090942171709440000.0);
  sp = fma(sp, r2, -1.0 / 121645100408832000.0);
  sp = fma(sp, r2, 1.0 / 355687428096000.0);
  sp = fma(sp, r2, -1.0 / 1307674368000.0);
  sp = fma(sp, r2, 1.0 / 6227020800.0);
  sp = fma(sp, r2, -1.0 / 39916800.0);
  sp = fma(sp, r2, 1.0 / 362880.0);
  sp = fma(sp, r2, -1.0 / 5040.0);
  sp = fma(sp, r2, 1.0 / 120.0);
  sp = fma(sp, r2, -1.0 / 6.0);
  sp = fma(sp, r2, 1.0);
  double cp = 1.0 / 620448401733239439360000.0;
  cp = fma(cp, r2, -1.0 / 1124000727777607680000.0);
  cp = fma(cp, r2, 1.0 / 2432902008176640000.0);
  cp = fma(cp, r2, -1.0 / 6402373705728000.0);
  cp = fma(cp, r2, 1.0 / 20922789888000.0);
  cp = fma(cp, r2, -1.0 / 87178291200.0);
  cp = fma(cp, r2, 1.0 / 479001600.0);
  cp = fma(cp, r2, -1.0 / 3628800.0);
  cp = fma(cp, r2, 1.0 / 40320.0);
  cp = fma(cp, r2, -1.0 / 720.0);
  cp = fma(cp, r2, 1.0 / 24.0);
  cp = fma(cp, r2, -0.5);
  cp = fma(cp, r2, 1.0);
  s = (float)(sp * r); c = (float)cp;
}

DI void phase_prep(const Params& p, char* lds) {
  u16* wt_in = (u16*)(p.ws + OFF_WIN); u16* wt_out = (u16*)(p.ws + OFF_WOUT);
  u16* wt_uq = (u16*)(p.ws + OFF_WUQ); u16* wt_ukv = (u16*)(p.ws + OFF_WUKV);
  constexpr int N_IN = 16 * 44, N_OUT = 16 * 16, N_UQ = 3 * 9, N_UKV = 2 * 12;
  constexpr int PER_L = N_IN + N_OUT + N_UQ + N_UKV;
  for (int it = blockIdx.x; it < DEPTH * PER_L; it += gridDim.x) {
    int l = it / PER_L, j = it % PER_L;
    if (j < N_IN) prep_transpose_tile(p.w_in + (size_t)l * DM * DIN, wt_in + (size_t)l * DIN * DM, DM, DIN, nullptr, j / 44, j % 44, (float*)lds);
    else if ((j -= N_IN) < N_OUT) prep_transpose_tile(p.w_out + (size_t)l * DM * DM, wt_out + (size_t)l * DM * DM, DM, DM, nullptr, j / 16, j % 16, (float*)lds);
    else if ((j -= N_OUT) < N_UQ) prep_transpose_tile(p.w_uq + (size_t)l * 192 * 576, wt_uq + (size_t)l * 576 * 192, 192, 576, p.qn + l * 192, j / 9, j % 9, (float*)lds);
    else { j -= N_UQ; prep_transpose_tile(p.w_ukv + (size_t)l * 128 * 768, wt_ukv + (size_t)l * 768 * 128, 128, 768, p.kvn + l * 128, j / 12, j % 12, (float*)lds); }
  }
  const size_t gtid = (size_t)blockIdx.x * NTHR + threadIdx.x, gsz = (size_t)gridDim.x * NTHR;
  u16* xb = (u16*)(p.ws + OFF_XB);
  for (size_t i = gtid; i < (size_t)T * DM / 8; i += gsz) {
    f32x4 a = *(const f32x4*)(p.x + i * 8), b = *(const f32x4*)(p.x + i * 8 + 4);
    u32x4 o = {pk2(a[0], a[1]), pk2(a[2], a[3]), pk2(b[0], b[1]), pk2(b[2], b[3])};
    *(u32x4*)(xb + i * 8) = o;
  }
  f32x2* rt = (f32x2*)(p.ws + OFF_ROPE);
  for (size_t i = gtid; i < (size_t)S * 16; i += gsz) {
    int pos = (int)(i >> 4), k = (int)(i & 15);
    float ang = (float)pos * ROPE_FREQ[k];
    float c, s; sincos_d((double)ang, c, s);
    f32x2 v = {c, s}; rt[i] = v;
  }
  if (blockIdx.x == 0 && threadIdx.x < DEPTH) {
    int l = threadIdx.x; const float* lv = p.lamv + l * 128;
    float d1 = 0.f, d2 = 0.f;
    for (int i = 0; i < 32; ++i) { d1 += lv[i] * lv[32 + i]; d2 += lv[64 + i] * lv[96 + i]; }
    float lam_init = 0.8f - 0.6f * expf(-0.3f * (float)l);
    float* lm = (float*)(p.ws + OFF_LAM);
    lm[l] = expf(d1) - expf(d2) + lam_init;
    lm[4 + l] = 1.0f - lam_init;
  }
}

#define LDS_BARRIER() asm volatile("s_waitcnt lgkmcnt(0)\n\ts_barrier" ::: "memory")
DI void gemm256(const u16* __restrict__ A, int lda, const u16* __restrict__ Bt, int ldb, int m0, int n0, int nvalid, int K,
                char* lds, f32x16 (&acc)[4][2], const float* cinit = nullptr) {
  constexpr int ASZ = 256 * 144, STG = 2 * ASZ;
  int tid_ = threadIdx.x; asm volatile("" : "+v"(tid_)); const int tid = tid_, lane = tid & 63, w = tid >> 6, l32 = lane & 31, hh = lane >> 5, wm = w & 1, wn = w >> 1;
  if (cinit) {
    const float* cp = cinit + (size_t)(m0 + 128 * wm + 4 * hh) * DM + (n0 + 64 * wn + l32);
#pragma unroll
    for (int mi = 0; mi < 4; ++mi)
#pragma unroll
      for (int ni = 0; ni < 2; ++ni)
#pragma unroll
        for (int r = 0; r < 16; ++r) acc[mi][ni][r] = ALPHA * cp[(32 * mi + (r & 3) + 8 * (r >> 2)) * DM + 32 * ni];
  } else {
#pragma unroll
    for (int mi = 0; mi < 4; ++mi)
#pragma unroll
      for (int ni = 0; ni < 2; ++ni)
#pragma unroll
        for (int r = 0; r < 16; ++r) acc[mi][ni][r] = 0.f;
  }
  u32x4 ra[4], rb[4];
  const int KT = K / 64;
  const int lrow = tid >> 3, lch = tid & 7;
  const u16* ap = A + (size_t)(m0 + lrow) * lda + lch * 8;
  const u16* bp = Bt + (size_t)(n0 + lrow) * ldb + lch * 8;
  auto gload = [&](int kt) {
#pragma unroll
    for (int i = 0; i < 4; ++i) ra[i] = *(const u32x4*)(ap + (size_t)(64 * i) * lda + kt * 64);
#pragma unroll
    for (int i = 0; i < 4; ++i) { u32x4 z = {0u, 0u, 0u, 0u};
      rb[i] = (lrow + 64 * i < nvalid) ? *(const u32x4*)(bp + (size_t)(64 * i) * ldb + kt * 64) : z; }
  };
  auto lstore = [&](int st) {
    char* As = lds + st * STG + lrow * 144 + lch * 16;
#pragma unroll
    for (int i = 0; i < 4; ++i) *(u32x4*)(As + 64 * i * 144) = ra[i];
#pragma unroll
    for (int i = 0; i < 4; ++i) *(u32x4*)(As + ASZ + 64 * i * 144) = rb[i];
  };
  auto compute = [&](int st) {
    const char* As = lds + st * STG + (128 * wm + l32) * 144 + hh * 16;
    const char* Bs = lds + st * STG + ASZ + (64 * wn + l32) * 144 + hh * 16;
    bf16x8 a0[4], b0[2], a1[4], b1[2];
#define LDFRAG(K16, AF, BF) do { _Pragma("unroll") for (int mi = 0; mi < 4; ++mi) AF[mi] = *(const bf16x8*)(As + 32 * mi * 144 + (K16) * 32); \
    _Pragma("unroll") for (int ni = 0; ni < 2; ++ni) BF[ni] = *(const bf16x8*)(Bs + 32 * ni * 144 + (K16) * 32); } while (0)
#define MMSTEP(AF, BF) do { _Pragma("unroll") for (int mi = 0; mi < 4; ++mi) _Pragma("unroll") for (int ni = 0; ni < 2; ++ni) acc[mi][ni] = MFMA(AF[mi], BF[ni], acc[mi][ni]); } while (0)
#define SGB(mask, n) __builtin_amdgcn_sched_group_barrier(mask, n, 0)
#define PIPE_STEP() do { SGB(0x100, 1); SGB(0x008, 1); SGB(0x100, 1); SGB(0x008, 1); SGB(0x100, 1); SGB(0x008, 1); SGB(0x100, 1); SGB(0x008, 1); \
    SGB(0x100, 1); SGB(0x008, 1); SGB(0x100, 1); SGB(0x008, 1); SGB(0x008, 2); } while (0)
    LDFRAG(0, a0, b0);
    LDFRAG(1, a1, b1); MMSTEP(a0, b0);
    LDFRAG(2, a0, b0); MMSTEP(a1, b1);
    LDFRAG(3, a1, b1); MMSTEP(a0, b0);
    MMSTEP(a1, b1);
    __builtin_amdgcn_iglp_opt(1);
#undef LDFRAG
#undef MMSTEP
#undef PIPE_STEP
  };
  gload(0); lstore(0);
  LDS_BARRIER();
  for (int kt = 0; kt < KT; ++kt) {
    if (kt + 1 < KT) gload(kt + 1);
    compute(kt & 1);
    if (kt + 1 < KT) lstore((kt + 1) & 1);
    LDS_BARRIER();
  }
}

DI int g8_lds_byte(int r, int c) { int st = (r >> 4) * 2 + (c >> 5), rr = r & 15, cc = c & 31, ob = rr * 64 + cc * 2; return st * 1024 + (ob ^ (((ob >> 9) & 1) << 5)); }
DI void g8_stage_rc(int b, int& R, int& C) { int st = b / 1024, sb = b % 1024, swz = sb ^ (((sb >> 9) & 1) << 5); R = (st >> 1) * 16 + swz / 64; C = (st & 1) * 32 + (swz % 64) / 2; }
DI void gemm8p(const u16* __restrict__ A, const u16* __restrict__ Bt, int brow, int bcol, f32x4 (&acc)[2][2][4][2]) {
  constexpr int K = 1024, BK = 64, HALF = 128, HT = HALF * BK;
  u16* shm = (u16*)lds_dyn;
#define G8_SA(b, h) (shm + ((b) * 2 + (h)) * HT)
#define G8_SB(b, h) (shm + (4 + (b) * 2 + (h)) * HT)
#define G8_STAGE(P, BASE, br, kt) do { const u16* gb_ = (BASE) + ((long)(br) * K + (long)(kt) * BK);     \
      __builtin_amdgcn_global_load_lds((const unsigned*)(gb_ + soff0), (__attribute__((address_space(3))) unsigned*)((char*)(P) + tid8 * 16), 16, 0, 0); \
      __builtin_amdgcn_global_load_lds((const unsigned*)(gb_ + soff1), (__attribute__((address_space(3))) unsigned*)((char*)(P) + tid8 * 16 + 8192), 16, 0, 0); } while (0)
#define G8_LDA(dst, b, h) for (int m = 0; m < 4; ++m) for (int k = 0; k < 2; ++k) \
    dst[m][k] = *reinterpret_cast<const bf16x8*>((char*)G8_SA(b, h) + g8_lds_byte(wr * 64 + m * 16 + fr, k * 32 + fq * 8))
#define G8_LDB(dst, b, h) for (int n = 0; n < 2; ++n) for (int k = 0; k < 2; ++k) \
    dst[n][k] = *reinterpret_cast<const bf16x8*>((char*)G8_SB(b, h) + g8_lds_byte(wc * 32 + n * 16 + fr, k * 32 + fq * 8))
#define G8_MMA(ai, bj, At_, Bt_) do { __builtin_amdgcn_s_setprio(1); \
    for (int m = 0; m < 4; ++m) for (int n = 0; n < 2; ++n) for (int k = 0; k < 2; ++k) \
      acc[ai][bj][m][n] = __builtin_amdgcn_mfma_f32_16x16x32_bf16(At_[m][k], Bt_[n][k], acc[ai][bj][m][n], 0, 0, 0); \
    __builtin_amdgcn_s_setprio(0); } while (0)
#define G8_WV(n) asm volatile("s_waitcnt vmcnt(" #n ")" ::: "memory")
#define G8_WL(n) asm volatile("s_waitcnt lgkmcnt(" #n ")" ::: "memory")
#define G8_BAR __builtin_amdgcn_s_barrier()
#define G8_SCHED __builtin_amdgcn_sched_barrier(0)
  int tid8 = threadIdx.x; asm volatile("" : "+v"(tid8));
  const int wid = tid8 >> 6, lane = tid8 & 63, wr = wid >> 2, wc = wid & 3, fr = lane & 15, fq = lane >> 4;
  int soff0, soff1;
  { int r_, c_; g8_stage_rc(tid8 * 16, r_, c_); soff0 = r_ * K + c_; g8_stage_rc(tid8 * 16 + 8192, r_, c_); soff1 = r_ * K + c_; }
  bf16x8 At[4][2], B0[2][2], B1[2][2];
  constexpr int nt = K / BK;
  __syncthreads();
  G8_STAGE(G8_SB(0, 0), Bt, bcol, 0); G8_STAGE(G8_SA(0, 0), A, brow, 0);
  G8_STAGE(G8_SB(0, 1), Bt, bcol + HALF, 0); G8_STAGE(G8_SA(0, 1), A, brow + HALF, 0);
  if (wr == 1) G8_BAR;
  G8_WV(4); G8_BAR;
  G8_STAGE(G8_SB(1, 0), Bt, bcol, 1); G8_STAGE(G8_SA(1, 0), A, brow, 1); G8_STAGE(G8_SB(1, 1), Bt, bcol + HALF, 1);
  G8_WV(6); G8_BAR;
#pragma unroll 1
  for (int t = 0; t < nt - 2; t += 2) {
    G8_LDB(B0, 0, 0); G8_SCHED; G8_LDA(At, 0, 0); G8_STAGE(G8_SA(1, 1), A, brow + HALF, t + 1);
    G8_WL(8); G8_BAR; G8_WL(0); G8_MMA(0, 0, At, B0); G8_BAR; G8_SCHED;
    G8_LDB(B1, 0, 1); G8_STAGE(G8_SB(0, 0), Bt, bcol, t + 2);
    G8_BAR; G8_WL(0); G8_MMA(0, 1, At, B1); G8_BAR;
    G8_LDA(At, 0, 1); G8_STAGE(G8_SA(0, 0), A, brow, t + 2);
    G8_BAR; G8_WL(0); G8_MMA(1, 0, At, B0); G8_BAR; G8_SCHED;
    G8_STAGE(G8_SB(0, 1), Bt, bcol + HALF, t + 2);
    G8_WV(6); G8_BAR; G8_MMA(1, 1, At, B1); G8_BAR;
    G8_LDB(B0, 1, 0); G8_SCHED; G8_LDA(At, 1, 0); G8_STAGE(G8_SA(0, 1), A, brow + HALF, t + 2);
    G8_WL(8); G8_BAR; G8_WL(0); G8_MMA(0, 0, At, B0); G8_BAR; G8_SCHED;
    G8_LDB(B1, 1, 1); G8_STAGE(G8_SB(1, 0), Bt, bcol, t + 3);
    G8_BAR; G8_WL(0); G8_MMA(0, 1, At, B1); G8_BAR;
    G8_LDA(At, 1, 1); G8_STAGE(G8_SA(1, 0), A, brow, t + 3);
    G8_BAR; G8_WL(0); G8_MMA(1, 0, At, B0); G8_BAR; G8_SCHED;
    G8_STAGE(G8_SB(1, 1), Bt, bcol + HALF, t + 3);
    G8_WV(6); G8_BAR; G8_MMA(1, 1, At, B1); G8_BAR;
  }
  { G8_LDB(B0, 0, 0); G8_LDA(At, 0, 0); G8_STAGE(G8_SA(1, 1), A, brow + HALF, nt - 1);
    G8_BAR; G8_WL(0); G8_MMA(0, 0, At, B0); G8_BAR;
    G8_LDB(B1, 0, 1); G8_BAR; G8_WL(0); G8_MMA(0, 1, At, B1); G8_BAR;
    G8_LDA(At, 0, 1); G8_WV(4); G8_BAR; G8_WL(0); G8_MMA(1, 0, At, B0); G8_MMA(1, 1, At, B1); G8_BAR; }
  { G8_LDB(B0, 1, 0); G8_LDA(At, 1, 0); G8_WV(2); G8_BAR; G8_WL(0); G8_MMA(0, 0, At, B0); G8_BAR;
    G8_LDB(B1, 1, 1); G8_WV(0); G8_BAR; G8_WL(0); G8_MMA(0, 1, At, B1); G8_BAR;
    G8_LDA(At, 1, 1); G8_BAR; G8_WL(0); G8_MMA(1, 0, At, B0); G8_MMA(1, 1, At, B1); G8_BAR; }
  if (wr == 0) G8_BAR;
#undef G8_SA
#undef G8_SB
#undef G8_STAGE
#undef G8_LDA
#undef G8_LDB
#undef G8_MMA
#undef G8_WV
#undef G8_WL
#undef G8_BAR
#undef G8_SCHED
}

DI void phase_inproj(const Params& p, int layer, char* lds) {
  const u16* xb = (const u16*)(p.ws + OFF_XB);
  const u16* wt = (const u16*)(p.ws + OFF_WIN) + (size_t)layer * DIN * DM;
  u16* H = (u16*)(p.ws + OFF_H);
  int tid_ = threadIdx.x; asm volatile("" : "+v"(tid_)); const int tid = tid_, lane = tid & 63, w = tid >> 6, l32 = lane & 31, hh = lane >> 5, wm = w & 1, wn = w >> 1;
  constexpr int NTN = 11, NRB = T / 256, NTILES = NRB * NTN;
  const float SC_DQ = 0.17677669529663687f * LOG2E, SC_SQ = 0.125f * LOG2E;
  const bool xcd_ok = (gridDim.x % 8) == 0;
  const int xj = xcd_ok ? (int)(blockIdx.x & 7) : 0, nbl = xcd_ok ? (int)(gridDim.x >> 3) : (int)gridDim.x;
  const int bl = xcd_ok ? (int)(blockIdx.x >> 3) : (int)blockIdx.x, per_x = xcd_ok ? NTILES / 8 : NTILES;
  for (int u = bl; u < per_x; u += nbl) {
    const int lr = u / NTN, nt = u % NTN;
    const int mt = xcd_ok ? lr * 8 + xj : lr, m0 = mt * 256, n0 = nt * 256;
    const int nvalid = (DIN - n0) < 256 ? (DIN - n0) : 256;
    (void)nvalid;
    f32x4 acc[2][2][4][2];
#pragma unroll
    for (int ai = 0; ai < 2; ++ai)
#pragma unroll
      for (int bj = 0; bj < 2; ++bj)
#pragma unroll
        for (int m = 0; m < 4; ++m)
#pragma unroll
          for (int n = 0; n < 2; ++n) acc[ai][bj][m][n] = (f32x4){0.f, 0.f, 0.f, 0.f};
    gemm8p(xb, wt, m0, n0, acc);
    const int wr8 = w >> 2, wc8 = w & 3, fr = lane & 15, fq = lane >> 4;
#pragma unroll
    for (int bj = 0; bj < 2; ++bj)
#pragma unroll
      for (int n = 0; n < 2; ++n) {
        const int cw = n0 + bj * 128 + wc8 * 32 + n * 16, col = cw + fr;
        u16* dst = H + cw; int dstr = DIN;
        {
          const int bb = m0 / S;
          if (cw >= C_DK && cw < C_DV) { const int o = cw - C_DK; dst = (u16*)(p.ws + OFF_DK) + ((size_t)(bb * 3 * S + (o >> 6) * S) << 6) + (o & 63); dstr = 64; }
          else if (cw >= C_DV && cw < C_SQ) { const int o = cw - C_DV; dst = (u16*)(p.ws + OFF_DV) + ((size_t)(bb * 3 * S + (o >> 6) * S) << 6) + (o & 63); dstr = 64; }
          else if (cw >= C_SK && cw < C_SV) { const int o = cw - C_SK; dst = (u16*)(p.ws + OFF_SK) + ((size_t)(bb * 1 * S + (o >> 6) * S) << 6) + (o & 63); dstr = 64; }
          else if (cw >= C_SV && cw < C_GATE) { const int o = cw - C_SV; dst = (u16*)(p.ws + OFF_SV) + ((size_t)(bb * 1 * S + (o >> 6) * S) << 6) + (o & 63); dstr = 64; }
        }
        if (cw < DIN) {
          float sc = 1.f;
          if (col >= C_DQ && col < C_DK) sc = SC_DQ;
          if (col >= C_SQ && col < C_SK) sc = SC_SQ;
          const bool gate = col >= C_GATE;
#pragma unroll
          for (int ai = 0; ai < 2; ++ai)
#pragma unroll
            for (int m = 0; m < 4; ++m) {
#pragma unroll
              for (int j = 0; j < 4; ++j) {
                const int row = m0 + ai * 128 + wr8 * 64 + m * 16 + fq * 4 + j;
                float v = acc[ai][bj][m][n][j] * sc;
                if (gate) v = v * __builtin_amdgcn_rcpf(1.f + __expf(-v));
                dst[(size_t)row * dstr + fr] = f2bf(v);
              }
              __builtin_amdgcn_sched_barrier(0);
            }
        }
      }
  }
}

DI void phase_mla_up(const Params& p, int layer, char* lds) {
  const u16* H = (const u16*)(p.ws + OFF_H);
  const u16* wuq = (const u16*)(p.ws + OFF_WUQ) + (size_t)layer * 576 * 192;
  const u16* wukv = (const u16*)(p.ws + OFF_WUKV) + (size_t)layer * 768 * 128;
  const f32x2* rt = (const f32x2*)(p.ws + OFF_ROPE);
  u16* QB = (u16*)(p.ws + OFF_QB); u16* KB = (u16*)(p.ws + OFF_KB); u16* VB = (u16*)(p.ws + OFF_VB);
  int tid_ = threadIdx.x; asm volatile("" : "+v"(tid_)); const int tid = tid_, lane = tid & 63, w = tid >> 6, l32 = lane & 31, hh = lane >> 5, wm = w & 3, wn = w >> 2;
  char* As = lds; char* Bs = lds + 128 * 400; float* rinv = (float*)(lds + 256 * 400);
  const float QSC = 0.10206207261596577f * LOG2E;
  for (int item = blockIdx.x; item < T / 128; item += gridDim.x) {
    const int m0 = item * 128;
#pragma unroll 1
    for (int part = 0; part < 2; ++part) {
      const int K = part == 0 ? 192 : 128, acol = part == 0 ? C_CQ : C_CKV, STR = (K + 8) * 2, CPR = K / 8;
      const int NCT = part == 0 ? 9 : 12;
      const u16* Wt = part == 0 ? wuq : wukv;
      __syncthreads();
      for (int c = tid; c < 128 * CPR; c += NTHR) { int row = c / CPR, ch = c % CPR;
        *(u32x4*)(As + row * STR + ch * 16) = *(const u32x4*)(H + (size_t)(m0 + row) * DIN + acol + ch * 8); }
      __syncthreads();
      {
        int row = tid >> 2, part4 = tid & 3, n = K / 4; float ss = 0.f;
        const u16* ar = (const u16*)(As + row * STR) + part4 * n;
        for (int i = 0; i < n; ++i) { float v = bf2f(ar[i]); ss += v * v; }
        ss += __shfl_xor(ss, 1); ss += __shfl_xor(ss, 2);
        if (part4 == 0) rinv[row] = rsqrtf(ss / (float)K + 1e-6f);
      }
      const int NCT2 = (NCT + 1) / 2, NOUT = NCT * 64;
      u32x4 rw[6];
      const __amdgpu_buffer_rsrc_t wrsrc = __builtin_amdgcn_make_buffer_rsrc((void*)Wt, 0, 1 << 30, 0x00027000);
      auto wload = [&](int ct) {
        int tl = tid; asm volatile("" : "+v"(tl));
#pragma unroll
        for (int i = 0; i < 6; ++i) { const int c = tl + NTHR * i; if (c < 128 * CPR) rw[i] = __builtin_amdgcn_raw_buffer_load_b128(wrsrc, c * 16, ct * 128 * K * 2, 0); }
      };
      __syncthreads();
      float rv[16];
#pragma unroll
      for (int r = 0; r < 16; ++r) rv[r] = rinv[32 * wm + crow(r, hh)] * (part == 0 ? QSC : 1.f);
      const int rowb = m0 + 32 * wm + 4 * hh;
      const int bq = m0 >> 13, srow = rowb & (S - 1);
      auto epi = [&](const f32x16& acc, const int c0) {
        if (part == 0) {
          const bool is_rope = (c0 % 96 == 64);
          u16* qp = QB + (size_t)rowb * QW + c0 + l32;
          const f32x2* rp = rt + (size_t)srow * 16 + (l32 & 15);
#pragma unroll
          for (int r = 0; r < 16; ++r) {
            const int ro = (r & 3) + 8 * (r >> 2);
            float v = acc[r] * rv[r];
            if (is_rope) {
              float o = __shfl_xor(v, 16);
              f32x2 cs = rp[ro * 16];
              v = (l32 < 16) ? (v * cs[0] - o * cs[1]) : (v * cs[0] + o * cs[1]);
            }
            qp[ro * QW] = (u16)(pk2(v, 0.f) & 0xffffu);
          }
        } else {
          const int head = c0 >> 7, within = c0 & 127;
          const size_t hrow = (size_t)(bq * 6 + head) * S + srow;
          if (within < 64) {
            u16* kp = KB + hrow * 96 + within + l32;
#pragma unroll
            for (int r = 0; r < 16; ++r) kp[((r & 3) + 8 * (r >> 2)) * 96] = (u16)(pk2(acc[r] * rv[r], 0.f) & 0xffffu);
          } else {
            u16* vp = VB + hrow * 64 + (within - 64) + l32;
#pragma unroll
            for (int r = 0; r < 16; ++r) vp[((r & 3) + 8 * (r >> 2)) * 64] = (u16)(pk2(acc[r] * rv[r], 0.f) & 0xffffu);
          }
        }
      };
      wload(0);
#pragma unroll 1
      for (int ct = 0; ct < NCT2; ++ct) {
        {
          int tl = tid; asm volatile("" : "+v"(tl));
#pragma unroll
          for (int i = 0; i < 6; ++i) { const int c = tl + NTHR * i, row = c / CPR, ch = c % CPR; if (c < 128 * CPR) *(u32x4*)(Bs + row * STR + ch * 16) = rw[i]; }
        }
        LDS_BARRIER();
        if (ct + 1 < NCT2) wload(ct + 1);
        f32x16 acc0, acc1;
#pragma unroll
        for (int r = 0; r < 16; ++r) { acc0[r] = 0.f; acc1[r] = 0.f; }
#define P2_MMA(NST, STRB) do { const char* ap_ = As + (32 * wm + l32) * (STRB) + hh * 16; const char* bp_ = Bs + (64 * wn + l32) * (STRB) + hh * 16; \
          _Pragma("unroll") for (int st = 0; st < (NST); ++st) { \
            bf16x8 af = *(const bf16x8*)(ap_ + st * 32); bf16x8 b0 = *(const bf16x8*)(bp_ + st * 32); bf16x8 b1 = *(const bf16x8*)(bp_ + 32 * (STRB) + st * 32); \
            acc0 = MFMA(af, b0, acc0); acc1 = MFMA(af, b1, acc1); } } while (0)
        if (part == 0) P2_MMA(12, 400); else P2_MMA(8, 272);
#undef P2_MMA
        const int c0 = ct * 128 + 64 * wn;
        if (c0 < NOUT) epi(acc0, c0);
        if (c0 + 32 < NOUT) epi(acc1, c0 + 32);
        LDS_BARRIER();
      }
    }
    for (int idx = tid; idx < 128 * 16; idx += NTHR) {
      const int row = idx >> 4, i = idx & 15, trow = m0 + row;
      float x1 = bf2f(H[(size_t)trow * DIN + C_KR + i]), x2 = bf2f(H[(size_t)trow * DIN + C_KR + 16 + i]);
      f32x2 cs = rt[(size_t)(trow & (S - 1)) * 16 + i];
      u16 o1 = f2bf(x1 * cs[0] - x2 * cs[1]), o2 = f2bf(x2 * cs[0] + x1 * cs[1]);
#pragma unroll
      for (int hd = 0; hd < 6; ++hd) { const size_t hrow = (size_t)((trow >> 13) * 6 + hd) * S + (trow & (S - 1)); KB[hrow * 96 + 64 + i] = o1; KB[hrow * 96 + 80 + i] = o2; }
    }
  }
}

constexpr int VSTR = 192;
template <int OFF>
DI void trread8(unsigned addr, s16x4 (&v)[8]) {
  asm volatile(
      "ds_read_b64_tr_b16 %0, %8 offset:%9\n\t"
      "ds_read_b64_tr_b16 %1, %8 offset:%10\n\t"
      "ds_read_b64_tr_b16 %2, %8 offset:%11\n\t"
      "ds_read_b64_tr_b16 %3, %8 offset:%12\n\t"
      "ds_read_b64_tr_b16 %4, %8 offset:%13\n\t"
      "ds_read_b64_tr_b16 %5, %8 offset:%14\n\t"
      "ds_read_b64_tr_b16 %6, %8 offset:%15\n\t"
      "ds_read_b64_tr_b16 %7, %8 offset:%16\n\t"
      "s_waitcnt lgkmcnt(0)"
      : "=&v"(v[0]), "=&v"(v[1]), "=&v"(v[2]), "=&v"(v[3]), "=&v"(v[4]), "=&v"(v[5]), "=&v"(v[6]), "=&v"(v[7])
      : "v"(addr), "i"(OFF + 0 * VSTR + 0), "i"(OFF + 8 * VSTR + 0), "i"(OFF + 0 * VSTR + 64), "i"(OFF + 8 * VSTR + 64),
        "i"(OFF + 16 * VSTR + 0), "i"(OFF + 24 * VSTR + 0), "i"(OFF + 16 * VSTR + 64), "i"(OFF + 24 * VSTR + 64)
      : "memory");
}

template <int MODE>
DI void attn_item(const Params& p, int layer, int bh, int qb, char* lds) {
  constexpr int KD = MODE == 0 ? 96 : 64, NMAP = MODE == 1 ? 2 : 1, QS = MODE == 0 ? 6 : (MODE == 1 ? 2 : 4);
  constexpr int KSTR = KD * 2 + 16, KBYTES = 64 * KSTR, VBYTES = 64 * VSTR, STAGE = KBYTES + VBYTES, KCH = (8 * KD + NTHR - 1) / NTHR, KCPR = KD / 8, KCHUNKS = 8 * KD;
  constexpr int BREL_BYTES = 2048;
  int tid_ = threadIdx.x; asm volatile("" : "+v"(tid_)); const int tid = tid_, lane = tid & 63, w = tid >> 6, l32 = lane & 31, hh = lane >> 5;
  const int q0 = qb * 256, q0w = q0 + 32 * w;
  const u16 *Qg, *Kg, *Vg; int qstr, kstr, vstr, ocol, b, hd;
  if (MODE == 0) {
    b = bh / 6; hd = bh % 6;
    Qg = (const u16*)(p.ws + OFF_QB) + (size_t)b * S * QW + hd * 96; qstr = QW;
    Kg = (const u16*)(p.ws + OFF_KB) + (size_t)(b * 6 + hd) * S * 96; kstr = 96;
    Vg = (const u16*)(p.ws + OFF_VB) + (size_t)(b * 6 + hd) * S * 64; vstr = 64;
    ocol = hd * 64;
  } else if (MODE == 1) {
    b = bh / 4; hd = bh % 4;
    const u16* Hb = (const u16*)(p.ws + OFF_H) + (size_t)b * S * DIN;
    Qg = Hb + C_DQ + hd * 64; qstr = DIN; kstr = vstr = 64;
    Kg = (const u16*)(p.ws + OFF_DK) + (size_t)(b * 4 + hd) * S * 64; Vg = (const u16*)(p.ws + OFF_DV) + (size_t)(b * 4 + hd) * S * 64;
    ocol = 384 + hd * 64;
  } else {
    b = bh / 6; hd = bh % 6;
    const u16* Hb = (const u16*)(p.ws + OFF_H) + (size_t)b * S * DIN;
    Qg = Hb + C_SQ + hd * 64; qstr = DIN; kstr = vstr = 64;
    Kg = (const u16*)(p.ws + OFF_SK) + (size_t)(b * 2 + hd / 3) * S * 64; Vg = (const u16*)(p.ws + OFF_SV) + (size_t)(b * 2 + hd / 3) * S * 64;
    ocol = 640 + hd * 64;
  }
  float* brel = (float*)lds;
  char* stage0 = lds + BREL_BYTES;
  if (MODE != 0) {
    const int bcol = MODE == 1 ? hd : 4 + hd;
    for (int i = tid; i < 512; i += NTHR) {
      int rel = i - 224, rc = rel < -128 ? -128 : (rel > 128 ? 128 : rel);
      float bv = p.relb[t5_bucket(rc) * 10 + bcol] * LOG2E;
      brel[i] = (MODE == 2 && rc != rel) ? -1e30f : bv;
    }
  }
  bf16x8 qf[NMAP][QS];
  {
    const u16* qrow = Qg + (size_t)(q0w + l32) * qstr + hh * 8;
#pragma unroll
    for (int mp = 0; mp < NMAP; ++mp)
#pragma unroll
      for (int st = 0; st < QS; ++st) qf[mp][st] = *(const bf16x8*)(qrow + (mp * QS + st) * 16);
  }
  f32x16 O[NMAP][2]; float m = 0.f, l[NMAP];
#pragma unroll
  for (int mp = 0; mp < NMAP; ++mp) {
#pragma unroll
    for (int r = 0; r < 16; ++r) { O[mp][0][r] = 0.f; O[mp][1][r] = 0.f; }
    l[mp] = 0.f;
  }
  if (MODE == 2) { m = p.sink[layer * 6 + hd] * LOG2E; l[0] = (hh == 0) ? 1.f : 0.f; }
  int kt0 = 0, kt1 = S / 64;
  if (MODE == 2) { kt0 = (q0 - 128) / 64; if (kt0 < 0) kt0 = 0; kt1 = (q0 + 384) / 64; if (kt1 > S / 64) kt1 = S / 64; }
  const int nt = kt1 - kt0;
  constexpr int KSTRG = MODE == 0 ? 96 : 64, VSTRG = 64;
  u32x4 rkA[KCH], rvA[1], rkB[KCH], rvB[1];
  const __amdgpu_buffer_rsrc_t krsrc = __builtin_amdgcn_make_buffer_rsrc((void*)Kg, 0, S * KSTRG * 2, 0x00027000);
  const __amdgpu_buffer_rsrc_t vrsrc = __builtin_amdgcn_make_buffer_rsrc((void*)Vg, 0, S * VSTRG * 2, 0x00027000);
  auto gload = [&](int kt, u32x4 (&rk)[KCH], u32x4 (&rv)[1]) {
    const int ksoff = kt * (64 * KSTRG * 2), vsoff = kt * (64 * VSTRG * 2);
#pragma unroll
    for (int i = 0; i < KCH; ++i) if (tid + NTHR * i < KCHUNKS) rk[i] = __builtin_amdgcn_raw_buffer_load_b128(krsrc, tid * 16 + NTHR * 16 * i, ksoff, 0);
    rv[0] = __builtin_amdgcn_raw_buffer_load_b128(vrsrc, tid * 16, vsoff, 0);
  };
  auto lstore = [&](int st, const u32x4 (&rk)[KCH], const u32x4 (&rv)[1]) {
    char* Ks = stage0 + st * STAGE;
#pragma unroll
    for (int i = 0; i < KCH; ++i) { int c = tid + NTHR * i, row = c / KCPR, ch = c % KCPR; if (c < KCHUNKS) *(u32x4*)(Ks + row * KSTR + ch * 16) = rk[i]; }
    { int row = tid >> 3, ch = tid & 7; *(u32x4*)(Ks + KBYTES + row * VSTR + ch * 16) = rv[0]; }
  };
  const unsigned vlane = (unsigned)((4 * hh + ((lane & 15) >> 2)) * VSTR + 32 * ((lane >> 4) & 1) + 8 * (lane & 3));
  bf16x8 kaug, qaug;
  { u32x4 tk = {hh == 0 ? 0x3F803F80u : 0u, 0u, 0u, 0u}; kaug = __builtin_bit_cast(bf16x8, tk); qaug = __builtin_bit_cast(bf16x8, (u32x4){0u, 0u, 0u, 0u}); }
  f32x16 c0p;
  auto set_c0 = [&](float c0) {
    const unsigned hi = f2bf(c0); const unsigned lo = f2bf(c0 - bf2f((u16)hi));
    u32x4 tq = {hh == 0 ? (hi | (lo << 16)) : 0u, 0u, 0u, 0u}; qaug = __builtin_bit_cast(bf16x8, tq);
    { const f32x16 z16 = {0.f, 0.f, 0.f, 0.f, 0.f, 0.f, 0.f, 0.f, 0.f, 0.f, 0.f, 0.f, 0.f, 0.f, 0.f, 0.f}; c0p = MFMA(kaug, qaug, z16); }
  };
  int c0cls = -1;
  auto compute = [&](const int t, const int cur) {
    const int k0 = (kt0 + t) * 64;
    const char* Ks = stage0 + cur * STAGE;
    bool active = true;
    if (MODE == 2) active = (k0 + 63 >= q0w - 128) && (k0 <= q0w + 159);
    if (active) {
      const float* brow = brel + (k0 - q0w - l32 + 4 * hh + 224);
      int cls = 0; float cb = 0.f;
      if (MODE == 1) {
        const int rmax = k0 + 63 - q0w, rmin = k0 - (q0w + 31);
        if (rmax <= -128) { cls = 1; cb = brel[224 - 128]; }
        else if (rmin >= 128) { cls = 2; cb = brel[224 + 128]; }
      }
      const bool far = cls != 0;
      if (cls != c0cls) { c0cls = cls; set_c0(cb - m); }
      const unsigned vaddr = (unsigned)(uintptr_t)(Ks + KBYTES) + vlane;
      typedef __attribute__((address_space(3))) s16x4 lds_s16x4;
      s16x4 vpre[16];
      u32x4 pk[NMAP][2][2];
#pragma unroll
      for (int mp = 0; mp < NMAP; ++mp) {
        f32x16 s[2];
        const f32x16 zero16 = {0.f, 0.f, 0.f, 0.f, 0.f, 0.f, 0.f, 0.f, 0.f, 0.f, 0.f, 0.f, 0.f, 0.f, 0.f, 0.f};
        __builtin_amdgcn_s_setprio(1);
        f32x16 c0tile;
        c0tile = c0p;
#pragma unroll
        for (int sub = 0; sub < 2; ++sub) {
#pragma unroll
          for (int st = 0; st < QS; ++st) {
            bf16x8 kf = *(const bf16x8*)(Ks + (32 * sub + l32) * KSTR + ((mp * QS + st) * 16 + hh * 8) * 2);
            if (st == 0) s[sub] = MFMA(kf, qf[mp][st], c0tile); else s[sub] = MFMA(kf, qf[mp][st], s[sub]);
          }
        }
        __builtin_amdgcn_iglp_opt(1);
        __builtin_amdgcn_s_setprio(0);
        if (NMAP == 1) {
          lds_s16x4* vb = (lds_s16x4*)(Ks + KBYTES + vlane);
#pragma unroll
          for (int i = 0; i < 16; ++i) {
            const int sub_ = i >> 3, ks_ = (i >> 2) & 1, dt_ = (i >> 1) & 1, g_ = i & 1;
            vpre[i] = __builtin_amdgcn_ds_read_tr16_b64_v4i16(vb + ((32 * sub_ + 16 * ks_ + 8 * g_) * VSTR + 64 * dt_) / 8);
          }
          __builtin_amdgcn_sched_barrier(0);
        }
        if (MODE != 0 && !far) {
#pragma unroll
          for (int sub = 0; sub < 2; ++sub)
#pragma unroll
            for (int r = 0; r < 16; ++r) s[sub][r] += brow[32 * sub + (r & 3) + 8 * (r >> 2)];
        }
        const bool first = (MODE != 2) && (t == 0) && (mp == 0);
        auto rebase = [&]() {
          float mx = fmaxf(fmaxf(s[0][0], s[0][1]), s[0][2]);
#pragma unroll
          for (int r = 3; r < 15; r += 2) mx = fmaxf(fmaxf(mx, s[0][r]), s[0][r + 1]);
          mx = fmaxf(mx, s[0][15]);
#pragma unroll
          for (int r = 0; r < 16; r += 2) mx = fmaxf(fmaxf(mx, s[1][r]), s[1][r + 1]);
          const float rm = xchg_max(mx);
          float delta = first ? rm : fmaxf(rm, 0.f);
          if (delta < -1e29f) delta = 0.f;
          m += delta;
          const float alpha = __builtin_amdgcn_exp2f(-delta);
#pragma unroll
          for (int mq = 0; mq < NMAP; ++mq) {
            l[mq] *= alpha;
#pragma unroll
            for (int r = 0; r < 16; ++r) { O[mq][0][r] *= alpha; O[mq][1][r] *= alpha; }
          }
#pragma unroll
          for (int r = 0; r < 16; ++r) { s[0][r] -= delta; s[1][r] -= delta; }
          set_c0(cb - m);
        };
        float ps;
        auto smpass = [&]() {
          ps = 0.f;
#pragma unroll
          for (int sub = 0; sub < 2; ++sub)
#pragma unroll
            for (int ks = 0; ks < 2; ++ks)
#pragma unroll
              for (int i = 0; i < 4; ++i) {
                const float p0 = __builtin_amdgcn_exp2f(s[sub][8 * ks + 2 * i]), p1 = __builtin_amdgcn_exp2f(s[sub][8 * ks + 2 * i + 1]);
                ps += p0 + p1; pk[mp][sub][ks][i] = pk2(p0, p1);
              }
        };
        if (first) rebase();
        smpass();
        if (!first && __any(!(ps <= PSLIM))) { rebase(); smpass(); }
        l[mp] += ps;
        __builtin_amdgcn_sched_barrier(0);
      }
#pragma unroll
      for (int sub = 0; sub < 2; ++sub) {
        s16x4 vv[8];
        if (NMAP == 1) {
#pragma unroll
          for (int i = 0; i < 8; ++i) vv[i] = vpre[sub * 8 + i];
        } else {
          if (sub == 0) trread8<0>(vaddr, vv); else trread8<32 * VSTR>(vaddr, vv);
        }
        __builtin_amdgcn_s_setprio(1);
#pragma unroll
        for (int ks = 0; ks < 2; ++ks) {
#pragma unroll
          for (int dt = 0; dt < 2; ++dt) {
            s16x4 lo = vv[ks * 4 + dt * 2], hi = vv[ks * 4 + dt * 2 + 1];
            bf16x8 vf = __builtin_shufflevector(lo, hi, 0, 1, 2, 3, 4, 5, 6, 7);
#pragma unroll
            for (int mp = 0; mp < NMAP; ++mp) O[mp][dt] = MFMA(vf, __builtin_bit_cast(bf16x8, pk[mp][sub][ks]), O[mp][dt]);
          }
        }
        __builtin_amdgcn_s_setprio(0);
        __builtin_amdgcn_sched_barrier(0);
      }
    }
  };
  __syncthreads();
  gload(kt0, rkA, rvA); lstore(0, rkA, rvA);
  if (nt > 1) gload(kt0 + 1, rkB, rvB);
  LDS_BARRIER();
  for (int t = 0; t < nt; t += 2) {
    if (t + 2 < nt) gload(kt0 + t + 2, rkA, rvA);
    compute(t, 0);
    if (t + 1 < nt) lstore(1, rkB, rvB);
    LDS_BARRIER();
    if (t + 1 >= nt) break;
    if (t + 3 < nt) gload(kt0 + t + 3, rkB, rvB);
    compute(t + 1, 1);
    if (t + 2 < nt) lstore(0, rkA, rvA);
    LDS_BARRIER();
  }
  __syncthreads();
  const size_t trow = (size_t)b * S + q0w + l32;
  const u16* grow = (const u16*)(p.ws + OFF_H) + trow * DIN + C_GATE + ocol;
  u16* orow = (u16*)(p.ws + OFF_OB) + trow * DM + ocol;
  float inv0 = 1.f / xchg_sum(l[0]);
  if (MODE == 1) {
    const float* lm = (const float*)(p.ws + OFF_LAM);
    const float lam = lm[layer], post = lm[4 + layer];
    const float inv1 = lam / xchg_sum(l[1]);
    float ss = 0.f;
#pragma unroll
    for (int dt = 0; dt < 2; ++dt)
#pragma unroll
      for (int r = 0; r < 16; ++r) { float v = O[0][dt][r] * inv0 - O[NMAP - 1][dt][r] * inv1; O[0][dt][r] = v; ss += v * v; }
    ss = xchg_sum(ss);
    inv0 = rsqrtf(ss * (1.f / 64.f) + 1e-6f) * post;
  }
#pragma unroll
  for (int dt = 0; dt < 2; ++dt)
#pragma unroll
    for (int g = 0; g < 4; ++g) {
      const int d = 32 * dt + 8 * g + 4 * hh;
      u32x2 gw = *(const u32x2*)(grow + d);
      float v0 = O[0][dt][4 * g + 0] * inv0, v1 = O[0][dt][4 * g + 1] * inv0, v2 = O[0][dt][4 * g + 2] * inv0, v3 = O[0][dt][4 * g + 3] * inv0;
      if (MODE == 1) { const float* sl = p.subln + layer * 64 + d; v0 *= sl[0]; v1 *= sl[1]; v2 *= sl[2]; v3 *= sl[3]; }
      v0 *= bflo(gw[0]); v1 *= bfhi(gw[0]); v2 *= bflo(gw[1]); v3 *= bfhi(gw[1]);
      u32x2 ow = {pk2(v0, v1), pk2(v2, v3)};
#ifdef PROBE_ZERO_MODE
      if (MODE == PROBE_ZERO_MODE) { ow[0] = 0u; ow[1] = 0u; }
#endif
      *(u32x2*)(orow + d) = ow;
    }
}

DI void phase_attn(const Params& p, int layer, char* lds) {
  constexpr int N_MLA = 24 * 32, N_DIFF = 16 * 32, N_SWA = 24 * 32;
  for (int g = blockIdx.x; g < N_MLA + N_DIFF + N_SWA; g += gridDim.x) {
    if (g < N_MLA) { int i = g; attn_item<0>(p, layer, (i & 7) + 8 * (i >> 8), (i >> 3) & 31, lds); }
    else if (g < N_MLA + N_DIFF) { int i = g - N_MLA; attn_item<1>(p, layer, (i & 7) + 8 * (i >> 8), (i >> 3) & 31, lds); }
    else { int i = g - N_MLA - N_DIFF; attn_item<2>(p, layer, (i & 7) + 8 * (i >> 8), (i >> 3) & 31, lds); }
  }
}

DI void phase_outproj(const Params& p, int layer, char* lds) {
  const u16* ob = (const u16*)(p.ws + OFF_OB);
  const u16* wt = (const u16*)(p.ws + OFF_WOUT) + (size_t)layer * DM * DM;
  const float* xres = layer == 0 ? p.x : p.out;
  float* xout = p.out;
  int tid_ = threadIdx.x; asm volatile("" : "+v"(tid_)); const int tid = tid_, lane = tid & 63, w = tid >> 6, l32 = lane & 31, hh = lane >> 5, wm = w & 1, wn = w >> 1;
  constexpr int NTN = DM / 256, NRB = T / 256, NTILES = NRB * NTN;
  const bool xcd_ok = (gridDim.x % 8) == 0;
  const int xj = xcd_ok ? (int)(blockIdx.x & 7) : 0, nbl = xcd_ok ? (int)(gridDim.x >> 3) : (int)gridDim.x;
  const int bl = xcd_ok ? (int)(blockIdx.x >> 3) : (int)blockIdx.x, per_x = xcd_ok ? NTILES / 8 : NTILES;
  for (int u = bl; u < per_x; u += nbl) {
    const int lr = u / NTN, nt = u % NTN, mt = xcd_ok ? lr * 8 + xj : lr, m0 = mt * 256, n0 = nt * 256;
    const int wr8 = w >> 2, wc8 = w & 3, fr = lane & 15, fq = lane >> 4;
    const size_t base = (size_t)(m0 + wr8 * 64 + fq * 4) * DM + (n0 + wc8 * 32 + fr);
    f32x4 acc[2][2][4][2];
#pragma unroll
    for (int ai = 0; ai < 2; ++ai)
#pragma unroll
      for (int bj = 0; bj < 2; ++bj)
#pragma unroll
        for (int m = 0; m < 4; ++m)
#pragma unroll
          for (int n = 0; n < 2; ++n) acc[ai][bj][m][n] = (f32x4){0.f, 0.f, 0.f, 0.f};
    gemm8p(ob, wt, m0, n0, acc);
    u16* yo = (u16*)(p.ws + OFF_XB) + base;
#pragma unroll
    for (int ai = 0; ai < 2; ++ai)
#pragma unroll
      for (int bj = 0; bj < 2; ++bj)
#pragma unroll
        for (int m = 0; m < 4; ++m) {
#pragma unroll
          for (int n = 0; n < 2; ++n)
#pragma unroll
            for (int j = 0; j < 4; ++j) yo[(ai * 128 + m * 16 + j) * DM + bj * 128 + n * 16] = f2bf(acc[ai][bj][m][n][j]);
          __builtin_amdgcn_sched_barrier(0);
        }
  }
}

DI void phase_ln(const Params& p, int layer) {
  const float* xres = layer == 0 ? p.x : p.out;
  float* xout = p.out;
  u16* xb = (u16*)(p.ws + OFF_XB);
  const float* lg = p.ln_g + layer * DM; const float* lb = p.ln_b + layer * DM;
  int tid_ = threadIdx.x; asm volatile("" : "+v"(tid_)); const int tid = tid_, lane = tid & 63, w = tid >> 6;
#pragma unroll 1
  for (size_t row = (size_t)blockIdx.x * 8 + w; row < (size_t)T; row += (size_t)gridDim.x * 8) {
    f32x4 v[4]; float sum = 0.f;
#pragma unroll
    for (int i = 0; i < 4; ++i) {
      const f32x4 xv = *(const f32x4*)(xres + row * DM + 4 * lane + 256 * i);
      const u32x2 yw = *(const u32x2*)(xb + row * DM + 4 * lane + 256 * i);
      v[i][0] = ALPHA * xv[0] + bflo(yw[0]); v[i][1] = ALPHA * xv[1] + bfhi(yw[0]); v[i][2] = ALPHA * xv[2] + bflo(yw[1]); v[i][3] = ALPHA * xv[3] + bfhi(yw[1]);
      sum += v[i][0] + v[i][1] + v[i][2] + v[i][3];
    }
    const float mu = wave_sum(sum) * (1.f / DM);
    float sq = 0.f;
#pragma unroll
    for (int i = 0; i < 4; ++i)
#pragma unroll
      for (int j = 0; j < 4; ++j) { float d = v[i][j] - mu; sq += d * d; }
    const float rstd = rsqrtf(wave_sum(sq) * (1.f / DM) + 1e-5f);
#pragma unroll
    for (int i = 0; i < 4; ++i) {
      const int col = 4 * lane + 256 * i;
      f32x4 g = *(const f32x4*)(lg + col), bb = *(const f32x4*)(lb + col), o;
#pragma unroll
      for (int j = 0; j < 4; ++j) o[j] = (v[i][j] - mu) * rstd * g[j] + bb[j];
      *(f32x4*)(xout + row * DM + col) = o;
      if (layer + 1 < DEPTH) {
        u32x2 ow = {pk2(o[0], o[1]), pk2(o[2], o[3])};
        *(u32x2*)(xb + row * DM + col) = ow;
      }
    }
  }
}

#if MK_COOP
DI void fast_grid_sync(unsigned* ctr, unsigned& epoch) {
  asm volatile("s_waitcnt vmcnt(0) lgkmcnt(0)" ::: "memory");
  __syncthreads();
  epoch += 1u;
  if (threadIdx.x == 0) {
    __builtin_amdgcn_fence(__ATOMIC_RELEASE, "agent");
    asm volatile("s_waitcnt vmcnt(0)" ::: "memory");
    const unsigned target = epoch * gridDim.x;
    (void)__hip_atomic_fetch_add(ctr, 1u, __ATOMIC_RELAXED, __HIP_MEMORY_SCOPE_AGENT);
    unsigned spins = 0;
    while (__hip_atomic_load(ctr, __ATOMIC_RELAXED, __HIP_MEMORY_SCOPE_AGENT) < target) {
      __builtin_amdgcn_s_sleep(2);
      if (++spins > (1u << 26)) break;
    }
    __builtin_amdgcn_fence(__ATOMIC_ACQUIRE, "agent");
    asm volatile("s_waitcnt vmcnt(0)" ::: "memory");
  }
  __syncthreads();
}

__global__ void __launch_bounds__(NTHR) fwd_megakernel(Params p) {
  char* lds = lds_dyn;
  cg::grid_group grid = cg::this_grid();
  unsigned* bar_ctr = (unsigned*)(p.ws + OFF_BAR); unsigned bar_epoch = 0;
  phase_prep(p, lds);
  grid.sync();
  for (int layer = 0; layer < DEPTH; ++layer) {
    phase_inproj(p, layer, lds);
    fast_grid_sync(bar_ctr, bar_epoch);
    phase_mla_up(p, layer, lds);
    fast_grid_sync(bar_ctr, bar_epoch);
#ifdef PROBE_REP_P12
    phase_inproj(p, layer, lds);
    fast_grid_sync(bar_ctr, bar_epoch);
    phase_mla_up(p, layer, lds);
    fast_grid_sync(bar_ctr, bar_epoch);
#endif
#ifdef PROBE_REP_P2
    phase_mla_up(p, layer, lds);
    fast_grid_sync(bar_ctr, bar_epoch);
#endif
    phase_attn(p, layer, lds);
#ifdef PROBE_REP_ATTN
    fast_grid_sync(bar_ctr, bar_epoch);
    phase_attn(p, layer, lds);
#endif
    fast_grid_sync(bar_ctr, bar_epoch);
    phase_outproj(p, layer, lds);
    fast_grid_sync(bar_ctr, bar_epoch);
    phase_ln(p, layer);
    if (layer + 1 < DEPTH) fast_grid_sync(bar_ctr, bar_epoch);
  }
}
#else
template <int PH>
__global__ void __launch_bounds__(NTHR, 2) phase_kernel(Params p, int layer) {
  __shared__ __attribute__((aligned(16))) char lds[LDS_BYTES];
  if (PH == 0) phase_prep(p, lds);
  if (PH == 1) phase_inproj(p, layer, lds);
  if (PH == 2) phase_mla_up(p, layer, lds);
  if (PH == 3) phase_attn(p, layer, lds);
  if (PH == 4) phase_outproj(p, layer, lds);
  if (PH == 5) phase_ln(p, layer);
}
#endif

extern "C" void kernel_launch(void* const* d_in, const int* in_sizes, int n_in, void* d_out, int out_size, void* d_ws, size_t ws_size,
                              hipStream_t stream) {
  if (n_in != 13 || ws_size < WS_END || out_size != T * DM) {
    fprintf(stderr, "kernel_launch: unexpected shapes n_in %d ws %zu (need %zu) out %d\n", n_in, ws_size, WS_END, out_size);
    return;
  }
  Params p{};
  p.x = (const float*)d_in[0]; p.w_in = (const float*)d_in[1]; p.qn = (const float*)d_in[2]; p.kvn = (const float*)d_in[3];
  p.w_uq = (const float*)d_in[4]; p.w_ukv = (const float*)d_in[5]; p.lamv = (const float*)d_in[6]; p.subln = (const float*)d_in[7];
  p.sink = (const float*)d_in[8]; p.relb = (const float*)d_in[9]; p.w_out = (const float*)d_in[10]; p.ln_g = (const float*)d_in[11];
  p.ln_b = (const float*)d_in[12]; p.out = (float*)d_out; p.ws = (char*)d_ws;
#if MK_COOP
  static int grid_blocks = 0;
  if (!grid_blocks) {
    int dev = 0, cus = 0, per_cu = 0;
    hipGetDevice(&dev);
    hipDeviceGetAttribute(&cus, hipDeviceAttributeMultiprocessorCount, dev);
    if (hipFuncSetAttribute((const void*)fwd_megakernel, hipFuncAttributeMaxDynamicSharedMemorySize, LDS_BYTES) != hipSuccess)
      fprintf(stderr, "kernel_launch: hipFuncSetAttribute(%d B dynamic LDS) failed\n", LDS_BYTES);
    hipOccupancyMaxActiveBlocksPerMultiprocessor(&per_cu, fwd_megakernel, NTHR, LDS_BYTES);
    (void)hipGetLastError();
    (void)per_cu;
    grid_blocks = cus;
  }
  (void)hipMemsetAsync((char*)d_ws + OFF_BAR, 0, 256, stream);
  void* args[] = {&p};
  hipError_t e = hipLaunchCooperativeKernel((void*)fwd_megakernel, dim3(grid_blocks), dim3(NTHR), args, LDS_BYTES, stream);
  if (e != hipSuccess) fprintf(stderr, "cooperative launch failed: %s (grid %d)\n", hipGetErrorString(e), grid_blocks);
#else
  const int G = 512;
  hipLaunchKernelGGL(phase_kernel<0>, dim3(G), dim3(NTHR), 0, stream, p, 0);
  for (int l = 0; l < DEPTH; ++l) {
    hipLaunchKernelGGL(phase_kernel<1>, dim3(G), dim3(NTHR), 0, stream, p, l);
    hipLaunchKernelGGL(phase_kernel<2>, dim3(G), dim3(NTHR), 0, stream, p, l);
    hipLaunchKernelGGL(phase_kernel<3>, dim3(G), dim3(NTHR), 0, stream, p, l);
    hipLaunchKernelGGL(phase_kernel<4>, dim3(G), dim3(NTHR), 0, stream, p, l);
    hipLaunchKernelGGL(phase_kernel<5>, dim3(G), dim3(NTHR), 0, stream, p, l);
  }
#endif
}
```
